# Optimizing an MI355X kernel written in HIP

```python
import jax
import jax.numpy as jnp
from jax import lax
import numpy as np

D_MODEL = 1024
BATCH = 16
SEQ = 4096
DEPTH = 2

GRID_W = 64
CTX_LEN = 256
HEAD_DIM = 64
ATTN_SCALE = HEAD_DIM ** -0.5

NA_HEADS = 8
NA_WIDTH = NA_HEADS * HEAD_DIM
WIN_ROWS = 8
WIN_COLS = 16
QCOL_BLK = 16
KCOL_BAND = QCOL_BLK + WIN_COLS

POOL_WINDOWS = (2, 4, 8, 16)
POOL_GROUPS = 4
POOL_GW = 128
POOL_WIDTH = POOL_GROUPS * POOL_GW

SWA_HEADS = 8
SWA_KV_HEADS = 2
SWA_GROUP = SWA_HEADS // SWA_KV_HEADS
SWA_WIDTH = SWA_HEADS * HEAD_DIM
SWA_KV_WIDTH = SWA_KV_HEADS * HEAD_DIM
SWA_WINDOW = 128
SWA_BLK = 128
ROPE_THETA = 10000.0
ROPE_AXIS_DIM = HEAD_DIM // 2

N_BRANCHES = 3
BRANCH_W = 512
IN_DIM = 3 * NA_WIDTH + POOL_WIDTH + SWA_WIDTH + 2 * SWA_KV_WIDTH + N_BRANCHES * D_MODEL

N_GROUPS = 4
EXP_PER_GROUP = 8
N_EXPERTS = N_GROUPS * EXP_PER_GROUP
TOP_K = 2
D_EXPERT = 512
MOE_BLK = 128

N_MOD = 6
NORM_EPS = 1e-6
NEG_INF = -1e30

kernel_name = 'hybrid_natten_pool_swa_hmoe_dit'


def _in_slices():
    widths = (('a_q', NA_WIDTH), ('a_k', NA_WIDTH), ('a_v', NA_WIDTH), ('b_u', POOL_WIDTH),
              ('c_q', SWA_WIDTH), ('c_k', SWA_KV_WIDTH), ('c_v', SWA_KV_WIDTH),
              ('gates', N_BRANCHES * D_MODEL))
    out, off = {}, 0
    for name, w in widths:
        out[name] = slice(off, off + w)
        off += w
    return out


def rms_norm(x, g):
    xf = x.astype(jnp.float32)
    y = xf * lax.rsqrt(jnp.mean(xf * xf, axis=-1, keepdims=True) + NORM_EPS)
    return (y * g).astype(x.dtype)


def adaln_modulation(cvec, w_mod, b_mod):
    m = jax.nn.silu(cvec) @ w_mod + b_mod
    return jnp.split(m, N_MOD, axis=-1)


def modulate(h, shift, scale):
    return h * (1 + scale) + shift


def split_heads(t):
    return t.reshape(t.shape[:-1] + (t.shape[-1] // HEAD_DIM, HEAD_DIM))


def axial_rope_angles(n_tokens):
    t = jnp.arange(n_tokens, dtype=jnp.int32)
    row = (t // GRID_W).astype(jnp.float32)
    col = (t % GRID_W).astype(jnp.float32)
    inv = ROPE_THETA ** (-jnp.arange(0, ROPE_AXIS_DIM, 2, dtype=jnp.float32) / ROPE_AXIS_DIM)
    return row[:, None] * inv[None, :], col[:, None] * inv[None, :]


def _rotate(x, ang):
    cos = jnp.cos(ang)[None, :, None, :]
    sin = jnp.sin(ang)[None, :, None, :]
    x1, x2 = jnp.split(x, 2, axis=-1)
    return jnp.concatenate([x1 * cos - x2 * sin, x2 * cos + x1 * sin], axis=-1)


def axial_rotary(x, ang_r, ang_c):
    xr, xc = jnp.split(x, 2, axis=-1)
    return jnp.concatenate([_rotate(xr, ang_r), _rotate(xc, ang_c)], axis=-1).astype(x.dtype)


def context_attention(q, k, v, sink):
    n_keys = k.shape[1]
    s = jnp.einsum('bqhgd,bkhd->bhgqk', q, k, preferred_element_type=jnp.float32) * ATTN_SCALE
    if sink is not None:
        sink_col = jnp.broadcast_to(sink.astype(jnp.float32)[None, :, :, None, None], s.shape[:-1] + (1,))
        s = jnp.concatenate([s, sink_col], axis=-1)
    p = jax.nn.softmax(s, axis=-1)[..., :n_keys].astype(v.dtype)
    return jnp.einsum('bhgqk,bkhd->bqhgd', p, v)


def neighborhood_attention(q, k, v, kz, vz, rpb):
    B, S, H, dh = q.shape
    rows = S // GRID_W
    kh = min(WIN_ROWS, rows)
    ncb = GRID_W // QCOL_BLK
    qg = q.reshape(B, rows, ncb, QCOL_BLK, H, dh)
    kg = k.reshape(B, rows, GRID_W, H, dh)
    vg = v.reshape(B, rows, GRID_W, H, dh)
    qcol = np.arange(GRID_W).reshape(ncb, QCOL_BLK)
    band0 = np.clip(np.arange(ncb) * QCOL_BLK - WIN_COLS // 2, 0, GRID_W - KCOL_BAND)
    kcol = band0[:, None] + np.arange(KCOL_BAND)[None, :]
    wstart = np.clip(qcol - WIN_COLS // 2, 0, GRID_W - WIN_COLS)
    col_ok = (kcol[:, None, :] >= wstart[:, :, None]) & (kcol[:, None, :] < wstart[:, :, None] + WIN_COLS)
    dcol_idx = np.clip(kcol[:, None, :] - qcol[:, :, None] + WIN_COLS - 1, 0, 2 * WIN_COLS - 2)
    n_win = kh * KCOL_BAND

    def row_block(r):
        r0 = jnp.clip(r - kh // 2, 0, rows - kh)
        kb = lax.dynamic_slice_in_dim(kg, r0, kh, axis=1)[:, :, kcol]
        vb = lax.dynamic_slice_in_dim(vg, r0, kh, axis=1)[:, :, kcol]
        qb = lax.dynamic_index_in_dim(qg, r, axis=1, keepdims=False)
        s_win = jnp.einsum('bjqhd,brjkhd->bhjqrk', qb, kb, preferred_element_type=jnp.float32) * ATTN_SCALE
        drow = r0 + jnp.arange(kh) - r + WIN_ROWS - 1
        bias = rpb[:, drow[None, None, :, None], dcol_idx[:, :, None, :]]
        s_win = jnp.where(col_ok[:, :, None, :], s_win + bias.astype(jnp.float32), NEG_INF)
        s_win = s_win.reshape(B, H, ncb, QCOL_BLK, n_win)
        s_ctx = jnp.einsum('bjqhd,bchd->bhjqc', qb, kz, preferred_element_type=jnp.float32) * ATTN_SCALE
        p = jax.nn.softmax(jnp.concatenate([s_win, s_ctx], axis=-1), axis=-1).astype(v.dtype)
        p_win = p[..., :n_win].reshape(B, H, ncb, QCOL_BLK, kh, KCOL_BAND)
        o = (jnp.einsum('bhjqrk,brjkhd->bjqhd', p_win, vb)
             + jnp.einsum('bhjqc,bchd->bjqhd', p[..., n_win:], vz))
        return o.reshape(B, GRID_W, H, dh)

    out = lax.map(row_block, jnp.arange(rows, dtype=jnp.int32))
    return out.transpose(1, 0, 2, 3, 4).reshape(B, S, H * dh)


def multiscale_pool(u, w_pool, pool_scale):
    B, L, _ = u.shape
    uf = u.astype(jnp.float32)
    cs = jnp.concatenate([jnp.zeros((B, 1, POOL_WIDTH), jnp.float32), jnp.cumsum(uf, axis=1)], axis=1)
    t = np.arange(L)
    diffs = []
    for g, w in enumerate(POOL_WINDOWS):
        lo = np.clip(t - w // 2, 0, L)
        hi = np.clip(t + w // 2, 0, L)
        csg = cs[..., g * POOL_GW:(g + 1) * POOL_GW]
        mean = (csg[:, hi] - csg[:, lo]) / (hi - lo).astype(np.float32)[None, :, None]
        diffs.append(mean - uf[..., g * POOL_GW:(g + 1) * POOL_GW])
    d = jnp.stack(diffs, axis=2).astype(u.dtype)
    y = jnp.einsum('blgc,gce->blge', d, w_pool).reshape(B, L, POOL_WIDTH)
    return y * pool_scale


def windowed_gqa_sink(q, k, v, kz, vz, sink):
    B, S, HQ, dh = q.shape
    nb = S // SWA_BLK
    qg = q.reshape(B, S, SWA_KV_HEADS, SWA_GROUP, dh)
    pad = ((0, 0), (SWA_BLK, SWA_BLK), (0, 0), (0, 0))
    kp = jnp.pad(k, pad)
    vp = jnp.pad(v, pad)
    rel = (np.arange(3 * SWA_BLK) - SWA_BLK)[None, :] - np.arange(SWA_BLK)[:, None]
    near = np.abs(rel) <= SWA_WINDOW
    sink_l = sink.astype(jnp.float32).reshape(SWA_KV_HEADS, SWA_GROUP)[None, :, :, None, None]
    n_win = 3 * SWA_BLK

    def block(i):
        q0 = i * SWA_BLK
        qb = lax.dynamic_slice_in_dim(qg, q0, SWA_BLK, axis=1)
        kb = lax.dynamic_slice_in_dim(kp, q0, n_win, axis=1)
        vb = lax.dynamic_slice_in_dim(vp, q0, n_win, axis=1)
        kpos = q0 - SWA_BLK + jnp.arange(n_win)
        ok = near & ((kpos >= 0) & (kpos < S))[None, :]
        s_win = jnp.einsum('bqhgd,bkhd->bhgqk', qb, kb, preferred_element_type=jnp.float32) * ATTN_SCALE
        s_win = jnp.where(ok, s_win, NEG_INF)
        s_ctx = jnp.einsum('bqhgd,bkhd->bhgqk', qb, kz, preferred_element_type=jnp.float32) * ATTN_SCALE
        s_sink = jnp.broadcast_to(sink_l, s_win.shape[:-1] + (1,))
        p = jax.nn.softmax(jnp.concatenate([s_win, s_ctx, s_sink], axis=-1), axis=-1).astype(v.dtype)
        o = (jnp.einsum('bhgqk,bkhd->bqhgd', p[..., :n_win], vb)
             + jnp.einsum('bhgqk,bkhd->bqhgd', p[..., n_win:n_win + kz.shape[1]], vz))
        return o.reshape(B, SWA_BLK, HQ * dh)

    out = lax.map(block, jnp.arange(nb, dtype=jnp.int32))
    return out.transpose(1, 0, 2, 3).reshape(B, S, HQ * dh)


def merge_branches(ya, yb, yc, gate_logits, w_branch, w_out):
    ga, gb, gc = jnp.split(jax.nn.sigmoid(gate_logits), N_BRANCHES, axis=-1)
    m = ga * (ya @ w_branch[0]) + gb * (yb @ w_branch[1]) + gc * (yc @ w_branch[2])
    return m @ w_out


def expert_dispatch(h, experts, weights, w_gate, w_up, w_down):
    T, D = h.shape
    n_assign = T * TOP_K
    n_slots = -(-(n_assign + N_EXPERTS * (MOE_BLK - 1)) // MOE_BLK) * MOE_BLK
    n_blk = n_slots // MOE_BLK
    flat_e = experts.reshape(n_assign)
    order = jnp.argsort(flat_e)
    sorted_e = flat_e[order]
    counts = jnp.bincount(flat_e, length=N_EXPERTS)
    padded = ((counts + MOE_BLK - 1) // MOE_BLK) * MOE_BLK
    pad_end = jnp.cumsum(padded)
    pad_start = pad_end - padded
    start = jnp.cumsum(counts) - counts
    dest = pad_start[sorted_e] + jnp.arange(n_assign, dtype=jnp.int32) - start[sorted_e]
    token_of_slot = jnp.full((n_slots,), T, jnp.int32).at[dest].set(order // TOP_K)
    h_pad = jnp.concatenate([h, jnp.zeros((1, D), h.dtype)], axis=0)
    xs = h_pad[token_of_slot].reshape(n_blk, MOE_BLK, D)
    block_expert = jnp.minimum(
        jnp.searchsorted(pad_end, jnp.arange(n_blk, dtype=jnp.int32) * MOE_BLK, side='right'),
        N_EXPERTS - 1).astype(jnp.int32)

    def run_block(args):
        xb, e = args
        return (jax.nn.silu(xb @ w_gate[e]) * (xb @ w_up[e])) @ w_down[e]

    ys = lax.map(run_block, (xs, block_expert)).reshape(n_slots, D)
    w_sorted = weights.reshape(n_assign)[order].astype(h.dtype)
    return jnp.zeros((T, D), h.dtype).at[order // TOP_K].add(ys[dest] * w_sorted[:, None])


def hierarchical_moe(h, w_rg, b_rg, w_re, b_re, w_gate, w_up, w_down):
    T = h.shape[0]
    lg = jnp.dot(h, w_rg, preferred_element_type=jnp.float32) + b_rg
    pg = jax.nn.softmax(lg, axis=-1)
    _, g_top = lax.top_k(lg, 1)
    p_grp = jnp.take_along_axis(pg, g_top, axis=-1)
    le = (jnp.dot(h, w_re, preferred_element_type=jnp.float32) + b_re).reshape(T, N_GROUPS, EXP_PER_GROUP)
    le_g = jnp.take_along_axis(le, g_top[:, :, None], axis=1)[:, 0]
    top_p, top_i = lax.top_k(jax.nn.softmax(le_g, axis=-1), TOP_K)
    top_p = top_p / jnp.sum(top_p, axis=-1, keepdims=True)
    weights = p_grp * top_p
    experts = (g_top * EXP_PER_GROUP + top_i).astype(jnp.int32)
    return expert_dispatch(h, experts, weights, w_gate, w_up, w_down)


def setup_inputs(seed: int = 0) -> dict:
    key = jax.random.key(seed)
    ks = jax.random.split(key, 23)
    f32 = jnp.float32

    def nrm(k, shape, std):
        return jax.random.normal(k, shape, f32) * std

    D = D_MODEL
    return {
        'x': nrm(ks[0], (BATCH, SEQ, D), 1.0),
        'c': nrm(ks[1], (BATCH, D), 1.0),
        'ctx': nrm(ks[2], (BATCH, CTX_LEN, D), 1.0),
        'c_ctx': nrm(ks[3], (D,), 1.0),
        'w_mod': nrm(ks[4], (DEPTH, D, N_MOD * D), D ** -0.5),
        'b_mod': nrm(ks[5], (DEPTH, N_MOD * D), 0.02),
        'norm1_g': 1.0 + nrm(ks[6], (DEPTH, D), 0.02),
        'norm2_g': 1.0 + nrm(ks[7], (DEPTH, D), 0.02),
        'w_in': nrm(ks[8], (DEPTH, D, IN_DIM), D ** -0.5),
        'rpb_a': nrm(ks[9], (DEPTH, NA_HEADS, 2 * WIN_ROWS - 1, 2 * WIN_COLS - 1), 0.5),
        'w_pool': nrm(ks[10], (DEPTH, POOL_GROUPS, POOL_GW, POOL_GW), POOL_GW ** -0.5),
        'pool_scale': 1.0 + nrm(ks[11], (DEPTH, POOL_WIDTH), 0.1),
        'sink_c': nrm(ks[12], (DEPTH, SWA_HEADS), 1.0),
        'w_branch': nrm(ks[13], (DEPTH, N_BRANCHES, BRANCH_W, D), BRANCH_W ** -0.5),
        'w_out': nrm(ks[14], (DEPTH, D, D), D ** -0.5),
        'w_router_group': nrm(ks[15], (DEPTH, D, N_GROUPS), D ** -0.5),
        'b_router_group': nrm(ks[16], (DEPTH, N_GROUPS), 0.01),
        'w_router_expert': nrm(ks[17], (DEPTH, D, N_EXPERTS), D ** -0.5),
        'b_router_expert': nrm(ks[18], (DEPTH, N_EXPERTS), 0.01),
        'w_exp_gate': nrm(ks[19], (DEPTH, N_EXPERTS, D, D_EXPERT), D ** -0.5),
        'w_exp_up': nrm(ks[20], (DEPTH, N_EXPERTS, D, D_EXPERT), D ** -0.5),
        'w_exp_down': nrm(ks[21], (DEPTH, N_EXPERTS, D_EXPERT, D), D_EXPERT ** -0.5),
        'final_g': 1.0 + nrm(ks[22], (D,), 0.02),
    }


def reference(x, c, ctx, c_ctx, w_mod, b_mod, norm1_g, norm2_g, w_in, rpb_a, w_pool, pool_scale,
              sink_c, w_branch, w_out, w_router_group, b_router_group, w_router_expert,
              b_router_expert, w_exp_gate, w_exp_up, w_exp_down, final_g):
    B, S, D = x.shape
    Lc = ctx.shape[1]
    sl = _in_slices()
    ang_r, ang_c = axial_rope_angles(S)
    z = ctx
    for l in range(DEPTH):
        last = l == DEPTH - 1
        mx = adaln_modulation(c[:, None, :], w_mod[l], b_mod[l])
        mz = adaln_modulation(c_ctx[None, None, :], w_mod[l], b_mod[l])

        hx = modulate(rms_norm(x, norm1_g[l]), mx[0], mx[1])
        hz = modulate(rms_norm(z, norm1_g[l]), mz[0], mz[1])
        px_all = hx @ w_in[l]
        px = {n: px_all[..., s] for n, s in sl.items()}
        if last:
            pz = {n: hz @ w_in[l][:, sl[n]] for n in ('a_k', 'a_v', 'c_k', 'c_v')}
        else:
            pz_all = hz @ w_in[l]
            pz = {n: pz_all[..., s] for n, s in sl.items()}
        kz_a, vz_a = split_heads(pz['a_k']), split_heads(pz['a_v'])
        kz_c, vz_c = split_heads(pz['c_k']), split_heads(pz['c_v'])

        ya = neighborhood_attention(split_heads(px['a_q']), split_heads(px['a_k']),
                                    split_heads(px['a_v']), kz_a, vz_a, rpb_a[l])
        yb = multiscale_pool(px['b_u'], w_pool[l], pool_scale[l])
        q_c = axial_rotary(split_heads(px['c_q']), ang_r, ang_c)
        k_c = axial_rotary(split_heads(px['c_k']), ang_r, ang_c)
        yc = windowed_gqa_sink(q_c, k_c, split_heads(px['c_v']), kz_c, vz_c, sink_c[l])
        x = x + mx[2] * merge_branches(ya, yb, yc, px['gates'], w_branch[l], w_out[l])

        if not last:
            za = context_attention(split_heads(pz['a_q'])[:, :, :, None, :], kz_a, vz_a, None)
            zb = multiscale_pool(pz['b_u'], w_pool[l], pool_scale[l])
            zq_c = split_heads(pz['c_q']).reshape(B, Lc, SWA_KV_HEADS, SWA_GROUP, HEAD_DIM)
            zc = context_attention(zq_c, kz_c, vz_c, sink_c[l].reshape(SWA_KV_HEADS, SWA_GROUP))
            z = z + mz[2] * merge_branches(za.reshape(B, Lc, NA_WIDTH), zb, zc.reshape(B, Lc, SWA_WIDTH),
                                           pz['gates'], w_branch[l], w_out[l])

        moe_params = (w_router_group[l], b_router_group[l], w_router_expert[l], b_router_expert[l],
                      w_exp_gate[l], w_exp_up[l], w_exp_down[l])
        hx = modulate(rms_norm(x, norm2_g[l]), mx[3], mx[4])
        if last:
            fx = hierarchical_moe(hx.reshape(B * S, D), *moe_params).reshape(B, S, D)
        else:
            hz = modulate(rms_norm(z, norm2_g[l]), mz[3], mz[4])
            tokens = jnp.concatenate([hz.reshape(B * Lc, D), hx.reshape(B * S, D)], axis=0)
            f = hierarchical_moe(tokens, *moe_params)
            z = z + mz[5] * f[:B * Lc].reshape(B, Lc, D)
            fx = f[B * Lc:].reshape(B, S, D)
        x = x + mx[5] * fx
    return rms_norm(x, final_g)
```

```cpp
#include <hip/hip_runtime.h>
#include <stdint.h>
#include <stdio.h>

#ifndef PROBE_REPMASK
#define PROBE_REPMASK 0
#endif
#ifndef PROBE_SUB
#define PROBE_SUB 14
#endif
#ifndef MK_PER_PHASE
#define MK_PER_PHASE 0
#endif

#define LAS __attribute__((address_space(3)))
typedef unsigned short bf16_t;
typedef short bf16x8 __attribute__((ext_vector_type(8)));
typedef float f32x4 __attribute__((ext_vector_type(4)));
typedef float f32x2 __attribute__((ext_vector_type(2)));
typedef unsigned u32x4 __attribute__((ext_vector_type(4)));
typedef unsigned u32x2 __attribute__((ext_vector_type(2)));
typedef int v4i __attribute__((ext_vector_type(4)));
typedef int v8i __attribute__((ext_vector_type(8)));
constexpr float W8SCALE = 32.0f, M8SCALE = 8.0f;

constexpr int D = 1024, NB = 16, SEQ = 4096, LC = 256, TX = NB * SEQ, TZ = NB * LC, T = TX + TZ;
constexpr int IN_DIM = 5888, OFF_AQ = 0, OFF_AK = 512, OFF_AV = 1024, OFF_BU = 1536, OFF_CQ = 2048, OFF_CK = 2560, OFF_CV = 2688, OFF_G = 2816;
constexpr int NIN = 2816;
constexpr int NEXP = 32, DE = 512, NSLOT = 147456;
constexpr float EPS = 1e-6f;
constexpr int NPH = 24;

constexpr size_t al256(size_t x) { return (x + 255) & ~(size_t)255; }
constexpr size_t WS_CTL = 0;
constexpr size_t CTL_BYTES = 65536;
constexpr size_t CTL_MODC = 53248;
constexpr size_t CTL_ZM = 49152;
constexpr size_t CTL_CNT = 32768;
constexpr size_t CTL_EXIT = 57344;
#if MK_PER_PHASE
#define CTLB(F) ((F).ws + WS_CTL)
#else
__device__ unsigned g_ctl[CTL_BYTES / 4];
#define CTLB(F) ((unsigned char*)g_ctl)
#endif
constexpr size_t WS_MOD = WS_CTL + CTL_BYTES;
constexpr size_t WS_ROPE = WS_MOD + al256((size_t)2 * 17 * 6144 * 4);
constexpr size_t WS_WIN = WS_ROPE + 8192;
constexpr size_t WS_WG = WS_WIN + (size_t)2 * NIN * 1024 * 2;
constexpr size_t WS_WB = WS_WG + (size_t)2 * 3 * 1024 * 1024 * 2;
constexpr size_t WS_WO = WS_WB + (size_t)2 * 3 * 1024 * 512 * 2;
constexpr size_t WS_WR = WS_WO + (size_t)2 * 1024 * 1024 * 2;
constexpr size_t WS_WGU = WS_WR + (size_t)2 * 256 * 1024 * 2;
constexpr size_t WS_WD = WS_WGU + (size_t)2 * 32 * 1024 * 1024 * 2;
constexpr size_t WS_XS = WS_WD + (size_t)2 * 32 * 1024 * 512 * 2;
constexpr size_t SZ_TD = (size_t)T * 1024 * 2, SZ_TH = (size_t)T * 512 * 2;
constexpr size_t WS_HX = WS_XS + SZ_TD;
constexpr size_t WS_QA = WS_HX + SZ_TD;
constexpr size_t WS_KA = WS_QA + SZ_TH;
constexpr size_t WS_M8 = WS_KA;
constexpr size_t WS_VAT = WS_KA + SZ_TH;
constexpr size_t WS_UB = WS_VAT + SZ_TH;
constexpr size_t WS_YB = WS_UB + SZ_TH;
constexpr size_t WS_QC = WS_YB + SZ_TH;
constexpr size_t WS_LOG = WS_QC + SZ_TH;
constexpr size_t WS_LTOK = WS_LOG + (size_t)T * 64 * 4;
constexpr size_t WS_LW = WS_LTOK + (size_t)32 * T * 4;
constexpr size_t WS_HX8 = WS_LW + (size_t)32 * T * 4;
constexpr size_t WS_WG8 = WS_HX8 + (size_t)T * 1024;
constexpr size_t WS_REC = WS_WG8 + (size_t)2 * 3072 * 1024;
constexpr size_t WS_RECW = WS_REC + (size_t)T * 4;
constexpr size_t WS_CNTC = WS_RECW + (size_t)T * 8;
constexpr size_t WS_END = WS_CNTC + (size_t)136 * 32 * 4;
constexpr size_t WS_YS2 = WS_QA;
static_assert((size_t)2 * T * 1024 * 2 == 4 * SZ_TH, "YS2 alias");
static_assert(WS_END <= ((size_t)1 << 30), "workspace");
static_assert(WS_YB == WS_QA + 4 * SZ_TH && WS_QC == WS_QA + 5 * SZ_TH, "merge operand spacing");
constexpr size_t DO_M = 0;
constexpr size_t DO_SIGS = DO_M + SZ_TD;
constexpr size_t DO_KC = DO_SIGS + (size_t)256 * 131072;
constexpr size_t DO_VCT = DO_KC + (size_t)T * 128 * 2;
constexpr size_t DO_END = DO_VCT + (size_t)T * 128 * 2;
constexpr size_t DO_ACT = 0;
static_assert((size_t)NSLOT * 512 * 2 <= DO_KC, "ACT alias");
static_assert(DO_END <= (size_t)TX * 1024 * 4, "d_out scratch");

constexpr int LDS_STAGE = 131072, LDS_X = 131072, LDS_BYTES = 131072 + 4096;

__device__ __forceinline__ unsigned cvt_pk_bf16(float lo, float hi) { unsigned r; asm volatile("v_cvt_pk_bf16_f32 %0, %1, %2" : "=v"(r) : "v"(lo), "v"(hi)); return r; }
__device__ __forceinline__ float sat8(float x) { return __builtin_amdgcn_fmed3f(x, 448.0f, -448.0f); }
__device__ __forceinline__ unsigned pk4_fp8(float a, float b, float c, float d) { int r = __builtin_amdgcn_cvt_pk_fp8_f32(sat8(a), sat8(b), 0, false); r = __builtin_amdgcn_cvt_pk_fp8_f32(sat8(c), sat8(d), r, true); return (unsigned)r; }
__device__ __forceinline__ float bf_lo(unsigned w) { return __uint_as_float(w << 16); }
__device__ __forceinline__ float bf_hi(unsigned w) { return __uint_as_float(w & 0xffff0000u); }
__device__ __forceinline__ float bf1(bf16_t v) { return __uint_as_float(((unsigned)v) << 16); }
__device__ __forceinline__ bf16_t f2bf(float f) { return (bf16_t)(cvt_pk_bf16(f, 0.f) & 0xffffu); }

#define XB_TMO      128
#define XB_XCNT(j)  (256  + 64 * (j))
#define XB_XSUB(j)  (1280 + 64 * (j))
#define XB_XGEN(j)  (2304 + 64 * (j))
#define XB_TOP      3328
#define XB_TOPGEN   3392
#define XCD_BAR_WORDS 3456
#define XB_SPIN_CAP (1u << 18)
__device__ __forceinline__ unsigned xb_ld(unsigned* p)              { return __hip_atomic_load(p, __ATOMIC_RELAXED, __HIP_MEMORY_SCOPE_AGENT); }
__device__ __forceinline__ unsigned xb_add(unsigned* p, unsigned v) { return __hip_atomic_fetch_add(p, v, __ATOMIC_RELAXED, __HIP_MEMORY_SCOPE_AGENT); }
__device__ __forceinline__ unsigned xb_xcc_id() { return (unsigned)__builtin_amdgcn_s_getreg((3 << 11) | 20) & 0xFu; }
#define XB_SPIN(cond, bar) do { unsigned _sp = 0; while (cond) { __builtin_amdgcn_s_sleep(1); \
    if ((++_sp & 255u) == 0u) { if (xb_ld(&(bar)[XB_TMO])) break; if (_sp > XB_SPIN_CAP) { atomicAdd(&(bar)[XB_TMO], 1u); break; } } } } while (0)
struct XcdBarrier { unsigned* bar; unsigned x; volatile LAS unsigned* st; };
__device__ __forceinline__ XcdBarrier xcd_barrier_post(unsigned* bar, volatile LAS unsigned* st) {
    XcdBarrier b; b.bar = bar; b.x = xb_xcc_id(); b.st = st;
    if (threadIdx.x == 0) (void)xb_add(&bar[XB_XCNT(b.x)], 1u);
    return b;
}
__device__ __forceinline__ void xcd_barrier_complete(unsigned* bar, unsigned x, unsigned& nloc, unsigned& nx) {
    const unsigned G = gridDim.x * gridDim.y * gridDim.z;
    unsigned sum, cnt, mine, sp = 0u;
    for (;;) {
        sum = 0u; cnt = 0u; mine = 0u;
#pragma unroll
        for (unsigned j = 0; j < 16; ++j) { const unsigned c = xb_ld(&bar[XB_XCNT(j)]); sum += c; cnt += (c > 0u) ? 1u : 0u; mine = (j == x) ? c : mine; }
        if (sum == G) break;
        __builtin_amdgcn_s_sleep(1);
        if ((++sp & 255u) == 0u) { if (xb_ld(&bar[XB_TMO])) break; if (sp > XB_SPIN_CAP) { atomicAdd(&bar[XB_TMO], 1u); break; } }
    }
    nloc = mine > 0u ? mine : 1u; nx = cnt > 0u ? cnt : 1u;
}
__device__ __forceinline__ void xcd_barrier(const XcdBarrier& b) {
    asm volatile("s_waitcnt vmcnt(0)" ::: "memory");
    __syncthreads();
    if (threadIdx.x == 0) {
        unsigned* bar = b.bar;
        __builtin_amdgcn_s_waitcnt(0);
        unsigned nloc = b.st[0], nx = b.st[1];
        if (nloc == 0u) { xcd_barrier_complete(bar, b.x, nloc, nx); b.st[0] = nloc; b.st[1] = nx; }
        const unsigned old = xb_add(&bar[XB_XSUB(b.x)], 1u);
        const unsigned gen = old / nloc;
        if (old + 1u == (gen + 1u) * nloc) {
            __builtin_amdgcn_fence(__ATOMIC_RELEASE, "agent");
            asm volatile("s_waitcnt vmcnt(0)" ::: "memory");
            const unsigned og = xb_add(&bar[XB_TOP], 1u);
            const unsigned tg = og / nx;
            if (og + 1u == (tg + 1u) * nx) xb_add(&bar[XB_TOPGEN], 1u);
            else XB_SPIN(xb_ld(&bar[XB_TOPGEN]) == tg, bar);
            __builtin_amdgcn_fence(__ATOMIC_ACQUIRE, "agent");
            xb_add(&bar[XB_XGEN(b.x)], 1u);
            asm volatile("s_waitcnt vmcnt(0)" ::: "memory");
        } else {
            XB_SPIN(xb_ld(&bar[XB_XGEN(b.x)]) == gen, bar);
            __builtin_amdgcn_fence(__ATOMIC_ACQUIRE, "agent");
            asm volatile("s_waitcnt vmcnt(0)" ::: "memory");
        }
    }
    __syncthreads();
}

__device__ __forceinline__ void zm_signal(unsigned* ctr) {
    asm volatile("s_waitcnt vmcnt(0)" ::: "memory");
    __syncthreads();
    if (threadIdx.x == 0) { __builtin_amdgcn_fence(__ATOMIC_RELEASE, "agent"); asm volatile("s_waitcnt vmcnt(0)" ::: "memory"); (void)xb_add(ctr, 1u); }
}
__device__ __forceinline__ void zm_wait(unsigned* ctr, unsigned need, unsigned* bar) {
    if (threadIdx.x == 0) { XB_SPIN(xb_ld(ctr) < need, bar); __builtin_amdgcn_fence(__ATOMIC_ACQUIRE, "agent"); asm volatile("s_waitcnt vmcnt(0)" ::: "memory"); }
    __syncthreads();
}

namespace gm {
constexpr int BM = 256, BK = 64, HALF = 128, HTB = HALF * BK * 2;
__device__ __forceinline__ int lds_byte(int r, int c) { const int st = (r >> 4) * 2 + (c >> 5), rr = r & 15, cc = c & 31, ob = rr * 64 + cc * 2; return st * 1024 + (ob ^ (((ob >> 9) & 1) << 5)); }
__device__ __forceinline__ void stage_rc(int b, int& R, int& C) { const int st = b / 1024, sb = b % 1024, swz = sb ^ (((sb >> 9) & 1) << 5); R = (st >> 1) * 16 + swz / 64; C = (st & 1) * 32 + (swz % 64) / 2; }
__device__ __forceinline__ int perm32(int rho) { const int n = rho >> 4, i = rho & 15; return 8 * (i >> 2) + 4 * n + (i & 3); }

struct GUnit {
    const char* A; const char* B;
    unsigned lda2, ldb2;
    int nt;
    const int* rows; int nrows;
    int pm, pn, a0, a1;
};
__device__ __forceinline__ bool static_tile(int L, int nM, int nN, int& pm, int& pn) {
    const int nwg = nM * nN; if (L >= nwg) return false;
    const int q = nwg / 8, r = nwg % 8, xcd = L % 8, off = L / 8;
    const int wgid = (xcd < r ? xcd * (q + 1) : r * (q + 1) + (xcd - r) * q) + off;
    const int nig = 8 * nN, gid = wgid / nig, fm = gid * 8, gsz = (nM - fm) < 8 ? (nM - fm) : 8;
    pm = fm + ((wgid % nig) % gsz); pn = (wgid % nig) / gsz; return true;
}

template <class Sched, class Epi, int SW, bool GATHER, int F8 = 0>
__device__ __forceinline__ void gemm_phase(LAS unsigned char* lds, const Sched& S, const Epi& E) {
    int tid = threadIdx.x; asm volatile("" : "+v"(tid));
    const int wid = __builtin_amdgcn_readfirstlane(tid >> 6), lane = tid & 63, wr = wid >> 2, wc = wid & 3, fr = lane & 15, fq = lane >> 4;
    const unsigned ldsw = (unsigned)wid * 1024u;
    const int aoff = lds_byte(wr * 64 + fr, fq * 8), boff = lds_byte(wc * 32 + fr, fq * 8);
#define PG8_SA(b, h) (((b) * 2 + (h)) * HTB)
#define PG8_SB(b, h) ((4 + (b) * 2 + (h)) * HTB)
#define PG8_LD2(bufoff, g0, o0, g1, o1) do { \
        __builtin_amdgcn_global_load_lds((const unsigned*)((const char*)(g0) + (o0)), (LAS unsigned*)(lds + (bufoff) + ldsw), 16, 0, 0); \
        __builtin_amdgcn_global_load_lds((const unsigned*)((const char*)(g1) + (o1)), (LAS unsigned*)(lds + (bufoff) + ldsw + 8192), 16, 0, 0); } while (0)
#define PG8_STA(bufoff, h, ap, ld, x0, x1, x2, x3) do { if constexpr (GATHER) { if ((h) == 0) PG8_LD2(bufoff, ap, x0, ap, x1); else PG8_LD2(bufoff, ap, x2, ap, x3); } \
        else PG8_LD2(bufoff, (ap) + (size_t)(h) * 128 * (ld), x0, (ap) + (size_t)((h) * 128 + 64) * (ld), x0); } while (0)
#define PG8_STB(bufoff, h, bp, ld, x) PG8_LD2(bufoff, (bp) + (size_t)(h) * 128 * (ld), x, (bp) + (size_t)((h) * 128 + 64) * (ld), x)
#define PG8_LDA(dst, b, h) do { _Pragma("unroll") for (int m = 0; m < 4; ++m) dst[m] = __builtin_shufflevector(*(const LAS v4i*)(lds + PG8_SA(b, h) + aoff + m * 2048), *(const LAS v4i*)(lds + PG8_SA(b, h) + aoff + m * 2048 + 1024), 0, 1, 2, 3, 4, 5, 6, 7); } while (0)
#define PG8_LDB(dst, b, h) do { _Pragma("unroll") for (int n = 0; n < 2; ++n) dst[n] = __builtin_shufflevector(*(const LAS v4i*)(lds + PG8_SB(b, h) + boff + n * 2048), *(const LAS v4i*)(lds + PG8_SB(b, h) + boff + n * 2048 + 1024), 0, 1, 2, 3, 4, 5, 6, 7); } while (0)
#define PG8_HALF(v, k) __builtin_bit_cast(bf16x8, (k) == 0 ? __builtin_shufflevector(v, v, 0, 1, 2, 3) : __builtin_shufflevector(v, v, 4, 5, 6, 7))
#define PG8_MMA(ai, bj, At, Bt) do { __builtin_amdgcn_s_setprio(1); _Pragma("unroll") for (int m = 0; m < 4; ++m) _Pragma("unroll") for (int n = 0; n < 2; ++n) _Pragma("unroll") for (int k = 0; k < 2; ++k) { \
        if constexpr (SW == 2 && (bj) == 1) acc[ai][bj][m][n] = __builtin_amdgcn_mfma_f32_16x16x32_bf16(PG8_HALF(At[m], k), PG8_HALF(Bt[n], k), acc[ai][bj][m][n], 0, 0, 0); \
        else acc[ai][bj][m][n] = __builtin_amdgcn_mfma_f32_16x16x32_bf16(PG8_HALF(Bt[n], k), PG8_HALF(At[m], k), acc[ai][bj][m][n], 0, 0, 0); } __builtin_amdgcn_s_setprio(0); } while (0)
#define PG8_MMA8(ai, bj, At, Bt) do { __builtin_amdgcn_s_setprio(1); _Pragma("unroll") for (int m = 0; m < 4; ++m) _Pragma("unroll") for (int n = 0; n < 2; ++n) { \
        acc[ai][bj][m][n] = __builtin_amdgcn_mfma_scale_f32_16x16x128_f8f6f4(Bt[n], At[m], acc[ai][bj][m][n], 0, 0, 0, 0x7f7f7f7f, 0, 0x7f7f7f7f); asm volatile("" ::: "memory"); } __builtin_amdgcn_s_setprio(0); } while (0)
#define PG8_MMAH(ai, bj, At, Bt) do { if constexpr ((bj) == 0) PG8_MMA(ai, bj, At, Bt); } while (0)
#define PG8_MMA8A(ai, bj, At, Bt) do { __builtin_amdgcn_s_setprio(1); _Pragma("unroll") for (int m = 0; m < 4; ++m) _Pragma("unroll") for (int n = 0; n < 2; ++n) { \
        asm volatile("v_mfma_scale_f32_16x16x128_f8f6f4 %0, %1, %2, %0, %3, %3 op_sel_hi:[0,0,0]" : "+v"(acc[ai][bj][m][n]) : "v"(Bt[n]), "v"(At[m]), "v"(one8)); } __builtin_amdgcn_s_setprio(0); } while (0)
#define PG8_WAIT_V(n) asm volatile("s_waitcnt vmcnt(" #n ")" ::: "memory")
#define PG8_WAIT_L(n) asm volatile("s_waitcnt lgkmcnt(" #n ")" ::: "memory")
#define PG8_BAR __builtin_amdgcn_s_barrier()
#define PG8_SCHED __builtin_amdgcn_sched_barrier(0)
#define PG8_OFFS(u, xa, xb) do { int t3 = threadIdx.x; asm volatile("" : "+v"(t3)); int R0, C0; stage_rc(t3 * 16, R0, C0); const int Rb0 = (R0 & ~31) + perm32(R0 & 31); const unsigned C20 = (unsigned)C0 * 2u; \
        if constexpr (GATHER) {   \
            const unsigned long long rv_ = (unsigned long long)(u).rows; const __attribute__((address_space(1))) int* rp_ = (const __attribute__((address_space(1))) int*)(((unsigned long long)(unsigned)__builtin_amdgcn_readfirstlane((int)(rv_ >> 32)) << 32) | (unsigned)__builtin_amdgcn_readfirstlane((int)(unsigned)rv_)); \
            const int nr_ = __builtin_amdgcn_readfirstlane((u).nrows); \
            _Pragma("unroll") for (int q = 0; q < 4; ++q) { const int row = q * 64 + R0; xa[q] = (unsigned)rp_[row < nr_ ? row : nr_ - 1]; } \
            _Pragma("unroll") for (int q = 0; q < 4; ++q) xa[q] = (xa[q] >> 1) * (u).lda2 + C20; } \
        else { xa[0] = (unsigned)R0 * (u).lda2 + C20; } \
        xb = (unsigned)Rb0 * (u).ldb2 + C20; } while (0)
#define PG8_KLOOP(MMAX) \
        for (int t = 0; t < nt; t += 2) { \
            const bool last = (t == nt - 2); \
            const char* a1 = cA + (size_t)(t + 1) * 128; \
            const char* a2 = last ? nA : cA + (size_t)(t + 2) * 128; const char* b2 = last ? nB : cB + (size_t)(t + 2) * 128; \
            const char* a3 = a2 + 128; const char* b3 = b2 + 128; \
            const unsigned la2 = last ? lan : la, lb2 = last ? lbn : lb; \
            unsigned xa[4]; \
_Pragma("unroll") \
            for (int q = 0; q < NOA; ++q) xa[q] = last ? pA[q] : oA[q]; \
            const unsigned xb = last ? pB : oB; \
 \
            PG8_LDB(B0, 0, 0); PG8_LDB(B1, 0, 1); PG8_SCHED; PG8_LDA(At, 0, 0); PG8_STA(PG8_SA(1, 1), 1, a1, la, oA[0], oA[1], oA[2], oA[3]); \
            PG8_WAIT_V(8); PG8_WAIT_L(0); PG8_BAR; MMAX(0, 0, At, B0); MMAX(0, 1, At, B1); PG8_BAR; PG8_SCHED; \
 \
            PG8_LDA(At, 0, 1); PG8_STB(PG8_SB(0, 0), 0, b2, lb2, xb); PG8_STB(PG8_SB(0, 1), 1, b2, lb2, xb); PG8_STA(PG8_SA(0, 0), 0, a2, la2, xa[0], xa[1], xa[2], xa[3]); \
            PG8_WAIT_V(8); PG8_WAIT_L(0); PG8_BAR; MMAX(1, 0, At, B0); MMAX(1, 1, At, B1); PG8_BAR; PG8_SCHED; \
 \
            PG8_LDB(B0, 1, 0); PG8_LDB(B1, 1, 1); PG8_SCHED; PG8_LDA(At, 1, 0); PG8_STA(PG8_SA(0, 1), 1, a2, la2, xa[0], xa[1], xa[2], xa[3]); \
            PG8_WAIT_V(8); PG8_WAIT_L(0); PG8_BAR; MMAX(0, 0, At, B0); MMAX(0, 1, At, B1); PG8_BAR; PG8_SCHED; \
 \
            PG8_LDA(At, 1, 1); PG8_STB(PG8_SB(1, 0), 0, b3, lb2, xb); PG8_STB(PG8_SB(1, 1), 1, b3, lb2, xb); PG8_STA(PG8_SA(1, 0), 0, a3, la2, xa[0], xa[1], xa[2], xa[3]); \
            PG8_WAIT_V(8); PG8_WAIT_L(0); PG8_BAR; MMAX(1, 0, At, B0); MMAX(1, 1, At, B1); PG8_BAR; PG8_SCHED; \
        }
    GUnit cur, nxt; int ui = 0;
    if (!S.next(0, cur)) return;
    f32x4 acc[2][2][4][2];
#pragma unroll
    for (int a = 0; a < 2; ++a)
#pragma unroll
        for (int b = 0; b < 2; ++b)
#pragma unroll
            for (int m = 0; m < 4; ++m)
#pragma unroll
                for (int n = 0; n < 2; ++n) acc[a][b][m][n] = (f32x4){0.f, 0.f, 0.f, 0.f};
    v8i At[4], B0[2], B1[2];
    int one8 = 0x7f7f7f7f; asm volatile("" : "+v"(one8));
    constexpr int NOA = GATHER ? 4 : 1;
    unsigned oA[4], pA[4], oB, pB;
    PG8_OFFS(cur, oA, oB);
    const char* cA = cur.A; const char* cB = cur.B; unsigned la = cur.lda2, lb = cur.ldb2; int nt = cur.nt;
    PG8_STB(PG8_SB(0, 0), 0, cB, lb, oB); PG8_STB(PG8_SB(0, 1), 1, cB, lb, oB); PG8_STA(PG8_SA(0, 0), 0, cA, la, oA[0], oA[1], oA[2], oA[3]); PG8_STA(PG8_SA(0, 1), 1, cA, la, oA[0], oA[1], oA[2], oA[3]);
    if (wr == 1) PG8_BAR;
    PG8_WAIT_V(2); PG8_BAR;
    PG8_STB(PG8_SB(1, 0), 0, cB + 128, lb, oB); PG8_STA(PG8_SA(1, 0), 0, cA + 128, la, oA[0], oA[1], oA[2], oA[3]); PG8_STB(PG8_SB(1, 1), 1, cB + 128, lb, oB);
    PG8_WAIT_V(6); PG8_BAR;
#define PG8_UNIT(MMAX) { \
        const bool has_next = S.next(ui + 1, nxt); \
        const char* nA = cA; const char* nB = cB; unsigned lan = la, lbn = lb; \
        if (has_next) { nA = nxt.A; nB = nxt.B; lan = nxt.lda2; lbn = nxt.ldb2; PG8_OFFS(nxt, pA, pB); } \
        else { \
_Pragma("unroll") \
            for (int q = 0; q < NOA; ++q) pA[q] = oA[q]; \
            pB = oB; \
        } \
        PG8_KLOOP(MMAX) \
        if constexpr (F8 == 5) { asm volatile("s_nop 15\n\ts_nop 15" ::: "memory"); }   \
        if (wr == 0) PG8_BAR; \
        { \
            int t2 = threadIdx.x; asm volatile("" : "+v"(t2)); \
            GUnit cu = cur; cu.pm = __builtin_amdgcn_readfirstlane(cu.pm); cu.pn = __builtin_amdgcn_readfirstlane(cu.pn); cu.a0 = __builtin_amdgcn_readfirstlane(cu.a0); asm volatile("" : "+s"(cu.pm), "+s"(cu.pn), "+s"(cu.a0)); \
            E(acc, cu, wr, wc, t2 & 15, (t2 & 63) >> 4); \
        } \
        if (!has_next) { done_ = true; } else { \
_Pragma("unroll") \
        for (int a = 0; a < 2; ++a) \
_Pragma("unroll") \
            for (int b = 0; b < 2; ++b) \
_Pragma("unroll") \
                for (int m = 0; m < 4; ++m) \
_Pragma("unroll") \
                    for (int n = 0; n < 2; ++n) acc[a][b][m][n] = (f32x4){0.f, 0.f, 0.f, 0.f}; \
        cur = nxt; cA = nA; cB = nB; la = lan; lb = lbn; nt = cur.nt; ++ui; \
_Pragma("unroll") \
        for (int q = 0; q < NOA; ++q) oA[q] = pA[q]; \
        oB = pB; \
        if (wr == 1) PG8_BAR; \
        } \
    }
    bool done_ = false;
    if constexpr (F8 == 1) {
        for (;;) { PG8_UNIT(PG8_MMA8) if (done_) break; PG8_UNIT(PG8_MMA) if (done_) break; }
    } else if constexpr (F8 == 2) {
        for (;;) { PG8_UNIT(PG8_MMA8) if (done_) break; }
    } else if constexpr (F8 == 5) {
        for (;;) { PG8_UNIT(PG8_MMA8A) if (done_) break; }
    } else if constexpr (F8 == 3) {
        for (;;) { PG8_UNIT(PG8_MMAH) if (done_) break; }
    } else {
        for (;;) { PG8_UNIT(PG8_MMA) if (done_) break; }
    }
    PG8_WAIT_V(0);
    PG8_BAR;
#undef PG8_SA
#undef PG8_SB
#undef PG8_LD2
#undef PG8_STA
#undef PG8_STB
#undef PG8_LDA
#undef PG8_LDB
#undef PG8_HALF
#undef PG8_MMA
#undef PG8_MMA8
#undef PG8_MMA8A
#undef PG8_MMAH
#undef PG8_KLOOP
#undef PG8_UNIT
#undef PG8_WAIT_V
#undef PG8_WAIT_L
#undef PG8_BAR
#undef PG8_SCHED
#undef PG8_OFFS
}
}
using gm::GUnit;

struct Params { const float* in[23]; float* out; unsigned char* ws; int ph_lo, ph_hi, flags, pad; };
enum { I_X = 0, I_C, I_CTX, I_CCTX, I_WMOD, I_BMOD, I_N1G, I_N2G, I_WIN, I_RPB, I_WPOOL, I_PSCALE, I_SINK, I_WBR, I_WOUT, I_WRG, I_BRG, I_WRE, I_BRE, I_WEG, I_WEU, I_WED, I_FING };

typedef const Params __attribute__((address_space(4))) KParams;
struct Frame {
    KParams* p; unsigned char* ws; unsigned char* dq; LAS unsigned char* lds;
    int tid, lane, wave, G, bx, vcu;
    __device__ __forceinline__ const float* mod(int l, int bb, int which) const { return (const float*)(ws + WS_MOD) + ((size_t)(l * 17 + bb) * 6 + which) * 1024; }
};
__device__ __forceinline__ Frame phase_frame(const Frame& F0) { Frame F = F0; int t = threadIdx.x; asm volatile("" : "+v"(t)); F.tid = t; F.lane = t & 63; F.wave = __builtin_amdgcn_readfirstlane(t >> 6); return F; }
__device__ __forceinline__ int row_batch(int row) { return row < TX ? (row >> 12) : 16; }

template <class ColF> __device__ __forceinline__ void conv_tile(const Frame& F, const float* src, int ld_src, bf16_t* dst, int K, int n0, int k0, ColF colf) {
    LAS float* tile = (LAS float*)F.lds;
    const int t = F.tid, n = t & 63; const int col = colf(n0 + n);
    { float v[32]; const float* sp = src + (size_t)(k0 + (t >> 6)) * ld_src + (col >= 0 ? col : 0);
#pragma unroll
      for (int i = 0; i < 32; ++i) v[i] = sp[(size_t)(8 * i) * ld_src];
#pragma unroll
      for (int i = 0; i < 32; ++i) tile[((t >> 6) + 8 * i) * 65 + n] = v[i]; }
    __syncthreads();
    const int nn = t >> 3, ks = t & 7;
#pragma unroll
    for (int j = 0; j < 4; ++j) { const int kk = (ks + 8 * j) * 8; u32x4 w;
        w.x = cvt_pk_bf16(tile[(kk + 0) * 65 + nn], tile[(kk + 1) * 65 + nn]); w.y = cvt_pk_bf16(tile[(kk + 2) * 65 + nn], tile[(kk + 3) * 65 + nn]);
        w.z = cvt_pk_bf16(tile[(kk + 4) * 65 + nn], tile[(kk + 5) * 65 + nn]); w.w = cvt_pk_bf16(tile[(kk + 6) * 65 + nn], tile[(kk + 7) * 65 + nn]);
        if (colf(n0 + nn) >= 0) *(u32x4*)(dst + (size_t)(n0 + nn) * K + k0 + kk) = w; }
    __syncthreads();
}
template <class ColF> __device__ __forceinline__ void conv_tile8(const Frame& F, const float* src, int ld_src, unsigned char* dst, int K, int n0, int k0, ColF colf) {
    LAS float* tile = (LAS float*)F.lds;
    const int t = F.tid, n = t & 63; const int col = colf(n0 + n);
    { float v[32]; const float* sp = src + (size_t)(k0 + (t >> 6)) * ld_src + col;
#pragma unroll
      for (int i = 0; i < 32; ++i) v[i] = sp[(size_t)(8 * i) * ld_src];
#pragma unroll
      for (int i = 0; i < 32; ++i) tile[((t >> 6) + 8 * i) * 65 + n] = v[i] * W8SCALE; }
    __syncthreads();
    const int nn = t >> 3, ks = t & 7;
#pragma unroll
    for (int j = 0; j < 4; ++j) { const int kk = (ks + 8 * j) * 8; u32x2 w;
        w.x = pk4_fp8(tile[(kk + 0) * 65 + nn], tile[(kk + 1) * 65 + nn], tile[(kk + 2) * 65 + nn], tile[(kk + 3) * 65 + nn]);
        w.y = pk4_fp8(tile[(kk + 4) * 65 + nn], tile[(kk + 5) * 65 + nn], tile[(kk + 6) * 65 + nn], tile[(kk + 7) * 65 + nn]);
        *(u32x2*)(dst + (size_t)(n0 + nn) * K + k0 + kk) = w; }
    __syncthreads();
}
__device__ __forceinline__ int win_col(int n) {
    const int tile = n >> 8, r = n & 255;
    if (tile < 2) return OFF_AQ + n;
    if (tile < 4) return -1;
    if (tile < 6 || tile == 10) {
        if (tile == 10 && r >= 128) return OFF_CV + (r - 128);
        const int base = tile == 10 ? OFF_CK : OFF_CQ + (tile - 4) * 256;
        const int head = r >> 6, p = r & 63, a = p >> 3, nn = (p >> 2) & 1, j = p & 3;
        const int dim = a < 4 ? (4 * a + j + 16 * nn) : (32 + 4 * (a - 4) + j + 16 * nn);
        return base + head * 64 + dim;
    }
    const int j = tile - 6;
    return r < 128 ? OFF_AK + 128 * j + r : OFF_AV + 128 * j + (r - 128);
}
constexpr int J_WIN = 176, J_WG = 192, J_WB = 96, J_WO = 64, J_WGU = 2048, J_WD = 1024, J_LAYER = J_WIN + J_WG + J_WB + J_WO + J_WGU + J_WD;
constexpr int J_CONV = 2 * J_LAYER, J_POOL = 128, J_MOD = 192, J_MISC = 3, J_ALL = J_CONV + J_POOL + J_MOD + J_MISC;
struct CJob { const float* sp; unsigned ld; unsigned char* dp; int is8; int ok; };
__device__ __forceinline__ CJob conv_decode(const Frame& F, int job) {
    KParams& P = *F.p; const int t = F.tid, n = t & 63, nn = t >> 3, ks = t & 7;
    const int l = job / J_LAYER; int j = job % J_LAYER;
    const float* src; int ld, K, n0, k0, is8, colL, ok = 1; unsigned char* dst;
    if (j < J_WIN) { const int nt_ = j >> 2, kt = j & 3; n0 = nt_ * 64; k0 = kt * 256; src = P.in[I_WIN] + (size_t)l * 1024 * IN_DIM; ld = IN_DIM; dst = F.ws + WS_WIN + (size_t)l * NIN * 2048; K = 1024; is8 = 0;
        colL = win_col(n0 + n); ok = win_col(n0 + nn) >= 0; colL = colL >= 0 ? colL : 0; }
    else if ((j -= J_WIN) < J_WG) { const int nt_ = j >> 2, kt = j & 3; n0 = nt_ * 64; k0 = kt * 256; src = P.in[I_WIN] + (size_t)l * 1024 * IN_DIM; ld = IN_DIM; dst = F.ws + WS_WG8 + (size_t)l * 3072 * 1024; K = 1024; is8 = 1; colL = OFF_G + n0 + n; }
    else if ((j -= J_WG) < J_WB) { const int br = j >> 5, jj = j & 31, nt_ = jj >> 1, kt = jj & 1; n0 = nt_ * 64; k0 = kt * 256; src = P.in[I_WBR] + (size_t)(l * 3 + br) * 512 * 1024; ld = 1024; dst = F.ws + WS_WB + (size_t)(l * 3 + br) * 1024 * 1024; K = 512; is8 = 0; colL = n0 + n; }
    else if ((j -= J_WB) < J_WO) { const int nt_ = j >> 2, kt = j & 3; n0 = nt_ * 64; k0 = kt * 256; src = P.in[I_WOUT] + (size_t)l * 1024 * 1024; ld = 1024; dst = F.ws + WS_WO + (size_t)l * 1024 * 1024; K = 1024; is8 = 1; colL = n0 + n; }
    else if ((j -= J_WO) < J_WGU) { const int e = j >> 6, jj = j & 63, nt_ = jj >> 2, kt = jj & 3; n0 = nt_ * 64; k0 = kt * 256;
        src = (((n0 >> 7) & 1) ? P.in[I_WEU] : P.in[I_WEG]) + (size_t)(l * 32 + e) * 1024 * 512; ld = 512; dst = F.ws + WS_WGU + (size_t)(l * 32 + e) * 1024 * 1024; K = 1024; is8 = 1;
        colL = (n0 >> 8) * 128 + (n0 & 127) + n; }
    else { j -= J_WGU; const int e = j >> 5, jj = j & 31, nt_ = jj >> 1, kt = jj & 1; n0 = nt_ * 64; k0 = kt * 256; src = P.in[I_WED] + (size_t)(l * 32 + e) * 512 * 1024; ld = 1024; dst = F.ws + WS_WD + (size_t)(l * 32 + e) * 1024 * 512; K = 512; is8 = 1; colL = n0 + n; }
    CJob c; c.sp = src + (size_t)(k0 + (t >> 6)) * ld + colL; c.ld = (unsigned)ld; c.dp = dst + ((size_t)(n0 + nn) * K + k0 + ks * 8) * (is8 ? 1 : 2); c.is8 = is8; c.ok = ok; return c;
}
#define P0_BAR do { asm volatile("s_waitcnt lgkmcnt(0)" ::: "memory"); __builtin_amdgcn_s_barrier(); asm volatile("" ::: "memory"); } while (0)
__device__ __forceinline__ void conv_jobs(const Frame& F, int& vj) {
    LAS float* tile = (LAS float*)F.lds;
    const int t = F.tid, n = t & 63, nn = t >> 3, ks = t & 7;
    CJob cur = conv_decode(F, vj - J_MOD);
    float v[32];
#pragma unroll
    for (int i = 0; i < 32; ++i) v[i] = cur.sp[(size_t)(8 * i) * cur.ld];
    for (;;) {
        const float scl = cur.is8 ? W8SCALE : 1.0f;
#pragma unroll
        for (int i = 0; i < 32; ++i) tile[((t >> 6) + 8 * i) * 65 + n] = v[i] * scl;
        P0_BAR;
        const int nvj = vj + F.G; const bool more = nvj < J_MOD + J_CONV;
        CJob nxt = cur; if (more) nxt = conv_decode(F, nvj - J_MOD);
#pragma unroll
        for (int i = 0; i < 32; ++i) v[i] = nxt.sp[(size_t)(8 * i) * nxt.ld];
        if (cur.is8) {
#pragma unroll
            for (int j = 0; j < 4; ++j) { const int kk = (ks + 8 * j) * 8; u32x2 w;
                w.x = pk4_fp8(tile[(kk + 0) * 65 + nn], tile[(kk + 1) * 65 + nn], tile[(kk + 2) * 65 + nn], tile[(kk + 3) * 65 + nn]);
                w.y = pk4_fp8(tile[(kk + 4) * 65 + nn], tile[(kk + 5) * 65 + nn], tile[(kk + 6) * 65 + nn], tile[(kk + 7) * 65 + nn]);
                *(u32x2*)(cur.dp + j * 64) = w; }
        } else {
#pragma unroll
            for (int j = 0; j < 4; ++j) { const int kk = (ks + 8 * j) * 8; u32x4 w;
                w.x = cvt_pk_bf16(tile[(kk + 0) * 65 + nn], tile[(kk + 1) * 65 + nn]); w.y = cvt_pk_bf16(tile[(kk + 2) * 65 + nn], tile[(kk + 3) * 65 + nn]);
                w.z = cvt_pk_bf16(tile[(kk + 4) * 65 + nn], tile[(kk + 5) * 65 + nn]); w.w = cvt_pk_bf16(tile[(kk + 6) * 65 + nn], tile[(kk + 7) * 65 + nn]);
                if (cur.ok) *(u32x4*)(cur.dp + j * 128) = w; }
        }
        P0_BAR;
        if (!more) break;
        cur = nxt; vj = nvj;
    }
}
__device__ __forceinline__ void p0_prologue(const Frame& F0) {
    const Frame F = phase_frame(F0);
    KParams& P = *F.p;
    for (int vj = F.bx; vj < J_ALL; vj += F.G) {
        const int job = vj < J_MOD ? J_CONV + J_POOL + vj : (vj < J_CONV + J_POOL + J_MOD ? vj - J_MOD : vj);
        if (job < J_CONV) { __syncthreads(); conv_jobs(F, vj); __syncthreads(); continue; }
        int j = job - J_CONV;
        if (j < J_POOL) {
            const int l = j >> 6, g = (j >> 4) & 3, kt = j & 15;
            LAS float* a = (LAS float*)F.lds; LAS float* wp = a + 64 * 128;
            const float* win = P.in[I_WIN] + (size_t)l * 1024 * IN_DIM; const float* wpool = P.in[I_WPOOL] + (size_t)(l * 4 + g) * 128 * 128;
            { f32x4 ta[4], tw[8];
#pragma unroll
              for (int q = 0; q < 4; ++q) { const int i4 = F.tid + 512 * q; ta[q] = *(const f32x4*)(win + (size_t)(kt * 64 + (i4 >> 5)) * IN_DIM + OFF_BU + g * 128 + (i4 & 31) * 4); }
#pragma unroll
              for (int q = 0; q < 8; ++q) tw[q] = *(const f32x4*)(wpool + (size_t)(F.tid + 512 * q) * 4);
#pragma unroll
              for (int q = 0; q < 4; ++q) *(LAS f32x4*)(a + (F.tid + 512 * q) * 4) = ta[q];
#pragma unroll
              for (int q = 0; q < 8; ++q) *(LAS f32x4*)(wp + (F.tid + 512 * q) * 4) = tw[q]; }
            __syncthreads();
            const int e = F.tid & 127, kq = F.tid >> 7; const float ps = P.in[I_PSCALE][l * 512 + g * 128 + e];
            float o[16];
#pragma unroll
            for (int kk = 0; kk < 16; ++kk) o[kk] = 0.f;
            for (int c = 0; c < 128; ++c) { const float w = wp[c * 128 + e];
#pragma unroll
                for (int kk = 0; kk < 16; ++kk) o[kk] += a[(kq * 16 + kk) * 128 + c] * w; }
            bf16_t* dst = (bf16_t*)(F.ws + WS_WIN) + ((size_t)l * NIN + 512 + g * 128 + e) * 1024 + kt * 64 + kq * 16;
            u32x4 w0, w1;
            w0.x = cvt_pk_bf16(o[0] * ps, o[1] * ps); w0.y = cvt_pk_bf16(o[2] * ps, o[3] * ps); w0.z = cvt_pk_bf16(o[4] * ps, o[5] * ps); w0.w = cvt_pk_bf16(o[6] * ps, o[7] * ps);
            w1.x = cvt_pk_bf16(o[8] * ps, o[9] * ps); w1.y = cvt_pk_bf16(o[10] * ps, o[11] * ps); w1.z = cvt_pk_bf16(o[12] * ps, o[13] * ps); w1.w = cvt_pk_bf16(o[14] * ps, o[15] * ps);
            *(u32x4*)dst = w0; *(u32x4*)(dst + 8) = w1;
            __syncthreads();
            continue;
        }
        j -= J_POOL;
        if (j < J_MOD) {
            const int l = j / 96, n0 = (j % 96) * 64;
            LAS float* sc = (LAS float*)F.lds;
            LAS float* part = sc + 17 * 1024;
            { float cv[34];
#pragma unroll
              for (int bb = 0; bb < 17; ++bb) { const float* src = bb < 16 ? P.in[I_C] + bb * 1024 : P.in[I_CCTX]; cv[2 * bb] = src[F.tid]; cv[2 * bb + 1] = src[F.tid + 512]; }
#pragma unroll
              for (int bb = 0; bb < 17; ++bb) { sc[bb * 1024 + F.tid] = cv[2 * bb] / (1.f + __expf(-cv[2 * bb])); sc[bb * 1024 + F.tid + 512] = cv[2 * bb + 1] / (1.f + __expf(-cv[2 * bb + 1])); } }
            __syncthreads();
            const float* wm = P.in[I_WMOD] + (size_t)l * 1024 * 6144 + n0 + F.lane;
            float acc[17];
#pragma unroll
            for (int b = 0; b < 17; ++b) acc[b] = 0.f;
            for (int kk = 0; kk < 128; kk += 32) {
                float w[32];
#pragma unroll
                for (int u = 0; u < 32; ++u) w[u] = wm[(size_t)(F.wave * 128 + kk + u) * 6144];
#pragma unroll
                for (int u = 0; u < 32; ++u)
#pragma unroll
                    for (int b = 0; b < 17; ++b) acc[b] += sc[b * 1024 + F.wave * 128 + kk + u] * w[u];
            }
#pragma unroll
            for (int b = 0; b < 17; ++b) part[(F.wave * 17 + b) * 64 + F.lane] = acc[b];
            __syncthreads();
            for (int i = F.tid; i < 17 * 64; i += 512) { const int b = i >> 6, n = i & 63; float s = P.in[I_BMOD][l * 6144 + n0 + n];
#pragma unroll
                for (int w = 0; w < 8; ++w) s += part[(w * 17 + b) * 64 + n];
                ((float*)(F.ws + WS_MOD))[(size_t)(l * 17 + b) * 6144 + n0 + n] = s; }
            zm_signal((unsigned*)(CTLB(F) + CTL_MODC));
            __syncthreads();
            continue;
        }
        j -= J_MOD;
        if (j < 2) {
            const int l = j; bf16_t* dst = (bf16_t*)(F.ws + WS_WR) + (size_t)l * 256 * 1024;
            for (int k = F.tid; k < 1024; k += 512) {
                const f32x4 g4 = *(const f32x4*)(P.in[I_WRG] + (size_t)(l * 1024 + k) * 4);
                f32x4 e4[8];
#pragma unroll
                for (int c = 0; c < 8; ++c) e4[c] = *(const f32x4*)(P.in[I_WRE] + (size_t)(l * 1024 + k) * 32 + 4 * c);
#pragma unroll
                for (int n = 0; n < 4; ++n) dst[(size_t)n * 1024 + k] = f2bf(g4[n]);
#pragma unroll
                for (int c = 0; c < 8; ++c)
#pragma unroll
                    for (int n = 0; n < 4; ++n) dst[(size_t)(4 + 4 * c + n) * 1024 + k] = f2bf(e4[c][n]);
            }
            for (int i = F.tid; i < 220 * 1024 / 8; i += 512) *(u32x4*)(dst + (size_t)36 * 1024 + (size_t)i * 8) = (u32x4){0u, 0u, 0u, 0u};
            continue;
        }
        {
            float* tab = (float*)(F.ws + WS_ROPE);
            for (int i = F.tid; i < 64 * 16; i += 512) { const int pos = i >> 4, f = i & 15; const float inv = powf(10000.0f, -(float)f / 16.0f); const float ang = (float)pos * inv;
                tab[2 * i] = cosf(ang); tab[2 * i + 1] = sinf(ang); }
        }
    }
}

__device__ __forceinline__ void ld16f(const float* p, float (&v)[16]) {
    const f32x4 a = *(const f32x4*)p, b = *(const f32x4*)(p + 4), c = *(const f32x4*)(p + 512), d = *(const f32x4*)(p + 516);
    v[0] = a[0]; v[1] = a[1]; v[2] = a[2]; v[3] = a[3]; v[4] = b[0]; v[5] = b[1]; v[6] = b[2]; v[7] = b[3];
    v[8] = c[0]; v[9] = c[1]; v[10] = c[2]; v[11] = c[3]; v[12] = d[0]; v[13] = d[1]; v[14] = d[2]; v[15] = d[3];
}
__device__ __forceinline__ void ld16b(const bf16_t* p, float (&v)[16]) {
    const u32x4 a = *(const u32x4*)p, c = *(const u32x4*)(p + 512);
    v[0] = bf_lo(a.x); v[1] = bf_hi(a.x); v[2] = bf_lo(a.y); v[3] = bf_hi(a.y); v[4] = bf_lo(a.z); v[5] = bf_hi(a.z); v[6] = bf_lo(a.w); v[7] = bf_hi(a.w);
    v[8] = bf_lo(c.x); v[9] = bf_hi(c.x); v[10] = bf_lo(c.y); v[11] = bf_hi(c.y); v[12] = bf_lo(c.z); v[13] = bf_hi(c.z); v[14] = bf_lo(c.w); v[15] = bf_hi(c.w);
}
__device__ __forceinline__ void st16b(bf16_t* p, const float (&v)[16]) {
    u32x4 a, c; a.x = cvt_pk_bf16(v[0], v[1]); a.y = cvt_pk_bf16(v[2], v[3]); a.z = cvt_pk_bf16(v[4], v[5]); a.w = cvt_pk_bf16(v[6], v[7]);
    c.x = cvt_pk_bf16(v[8], v[9]); c.y = cvt_pk_bf16(v[10], v[11]); c.z = cvt_pk_bf16(v[12], v[13]); c.w = cvt_pk_bf16(v[14], v[15]);
    *(u32x4*)p = a; *(u32x4*)(p + 512) = c;
}
__device__ __forceinline__ void st16f8(unsigned char* p, const float (&v)[16]) {
    u32x2 a, c; a.x = pk4_fp8(v[0], v[1], v[2], v[3]); a.y = pk4_fp8(v[4], v[5], v[6], v[7]); c.x = pk4_fp8(v[8], v[9], v[10], v[11]); c.y = pk4_fp8(v[12], v[13], v[14], v[15]);
    *(u32x2*)p = a; *(u32x2*)(p + 512) = c;
}
#define ROW_ROR_ADD(v, n) v += __uint_as_float((unsigned)__builtin_amdgcn_update_dpp(0, (int)__float_as_uint(v), 0x120 + (n), 0xf, 0xf, false))
__device__ __forceinline__ float wave_sum(float s) {
    ROW_ROR_ADD(s, 8); ROW_ROR_ADD(s, 4); ROW_ROR_ADD(s, 2); ROW_ROR_ADD(s, 1);
    auto r = __builtin_amdgcn_permlane32_swap(__float_as_uint(s), __float_as_uint(s), false, false); s = __uint_as_float(r[0]) + __uint_as_float(r[1]);
    auto q = __builtin_amdgcn_permlane16_swap(__float_as_uint(s), __float_as_uint(s), false, false); return __uint_as_float(q[0]) + __uint_as_float(q[1]);
}
__device__ __forceinline__ void norm_mod16(float (&v)[16], const float* g, const float* shift, const float* scale, int c0) {
    float s = 0.f;
#pragma unroll
    for (int i = 0; i < 16; ++i) s += v[i] * v[i];
    s = wave_sum(s);
    const float rstd = rsqrtf(s * (1.0f / 1024.0f) + EPS);
    float gg[16], sh[16], sc[16]; ld16f(g + c0, gg); ld16f(shift + c0, sh); ld16f(scale + c0, sc);
#pragma unroll
    for (int i = 0; i < 16; ++i) v[i] = (v[i] * rstd * gg[i]) * (1.0f + sc[i]) + sh[i];
}
__device__ __forceinline__ void norm_mod16p(float (&v)[16], const float (&gg)[16], const float (&sh)[16], const float (&sc)[16]) {
    float s = 0.f;
#pragma unroll
    for (int i = 0; i < 16; ++i) s += v[i] * v[i];
    s = wave_sum(s);
    const float rstd = rsqrtf(s * (1.0f / 1024.0f) + EPS);
#pragma unroll
    for (int i = 0; i < 16; ++i) v[i] = (v[i] * rstd * gg[i]) * (1.0f + sc[i]) + sh[i];
}
struct R16 { u32x4 a, c; };
struct F16 { f32x4 a, b, c, d; };
__device__ __forceinline__ R16 ldr16b(const bf16_t* p) { R16 r; r.a = *(const u32x4*)p; r.c = *(const u32x4*)(p + 512); return r; }
__device__ __forceinline__ F16 ldr16f(const float* p) { F16 r; r.a = *(const f32x4*)p; r.b = *(const f32x4*)(p + 4); r.c = *(const f32x4*)(p + 512); r.d = *(const f32x4*)(p + 516); return r; }
__device__ __forceinline__ void unp16b(const R16& r, float (&v)[16]) {
    v[0] = bf_lo(r.a.x); v[1] = bf_hi(r.a.x); v[2] = bf_lo(r.a.y); v[3] = bf_hi(r.a.y); v[4] = bf_lo(r.a.z); v[5] = bf_hi(r.a.z); v[6] = bf_lo(r.a.w); v[7] = bf_hi(r.a.w);
    v[8] = bf_lo(r.c.x); v[9] = bf_hi(r.c.x); v[10] = bf_lo(r.c.y); v[11] = bf_hi(r.c.y); v[12] = bf_lo(r.c.z); v[13] = bf_hi(r.c.z); v[14] = bf_lo(r.c.w); v[15] = bf_hi(r.c.w);
}
__device__ __forceinline__ void unp16f(const F16& r, float (&v)[16]) {
    v[0] = r.a[0]; v[1] = r.a[1]; v[2] = r.a[2]; v[3] = r.a[3]; v[4] = r.b[0]; v[5] = r.b[1]; v[6] = r.b[2]; v[7] = r.b[3];
    v[8] = r.c[0]; v[9] = r.c[1]; v[10] = r.c[2]; v[11] = r.c[3]; v[12] = r.d[0]; v[13] = r.d[1]; v[14] = r.d[2]; v[15] = r.d[3];
}
__device__ __forceinline__ void opq(F16& r) { asm volatile("" : "+v"(r.a), "+v"(r.b), "+v"(r.c), "+v"(r.d) :: "memory"); }
__device__ __forceinline__ void opq(R16& r) { asm volatile("" : "+v"(r.a), "+v"(r.c) :: "memory"); }
#define RP_SB __builtin_amdgcn_sched_barrier(0)
#define ROWPASS_RUN(ns, exact) do { \
        if ((exact) && (ns) >= 2) {     \
            PSet A = LD(0), B = LD(1); \
            OPQ(A); PR(0, A, false); RP_SB; A = LD(2 < (ns) ? 2 : 0); RP_SB; OPQ(B); PR(1, B, false); RP_SB; B = LD(3 < (ns) ? 3 : 0); RP_SB; \
            int s_ = 2; \
            for (; s_ + 2 <= (ns); s_ += 2) { OPQ(A); PR(s_, A, false); RP_SB; A = LD(s_ + 2 < (ns) ? s_ + 2 : 0); RP_SB; OPQ(B); PR(s_ + 1, B, false); RP_SB; B = LD(s_ + 3 < (ns) ? s_ + 3 : 0); RP_SB; } \
            if (s_ < (ns)) { OPQ(A); PR(s_, A, false); } \
        } else { \
            for (int s_ = 0; s_ < (ns); ++s_) { const PSet t_ = LD(s_); PR(s_, t_, true); } \
        } } while (0)
__device__ __forceinline__ void p_norm_in(const Frame& F0) {
    const Frame F = phase_frame(F0);
    KParams& P = *F.p; const int c0 = F.lane * 8, S = F.G * 8;
    zm_wait((unsigned*)(CTLB(F) + CTL_MODC), 192u, (unsigned*)CTLB(F));
    struct PSet { F16 a, b, sh, sc; };
    const int r0 = F.vcu * 8 + F.wave;
    float gg[16]; ld16f(P.in[I_N1G] + c0, gg);
    auto rowp = [&](int r) -> const float* { return (r < TX ? P.in[I_X] + (size_t)r * 1024 : P.in[I_CTX] + (size_t)(r - TX) * 1024) + c0; };
    auto LD = [&](int s_) -> PSet { int ra = r0 + 2 * s_ * S, rb = ra + S; ra = ra < T ? ra : r0; rb = rb < T ? rb : r0; const int bb = row_batch(ra); PSet t;
        t.a = ldr16f(rowp(ra)); t.b = ldr16f(rowp(rb)); t.sh = ldr16f(F.mod(0, bb, 0) + c0); t.sc = ldr16f(F.mod(0, bb, 1) + c0); return t; };
    auto ROW = [&](int r, const F16& raw, const PSet& t, bool pred) { if (!pred || r < T) { float v[16], sh[16], sc[16]; unp16f(raw, v); unp16f(t.sh, sh); unp16f(t.sc, sc); norm_mod16p(v, gg, sh, sc);
        st16b((bf16_t*)(F.ws + WS_HX) + (size_t)r * 1024 + c0, v); st16f8((unsigned char*)(F.ws + WS_HX8) + (size_t)r * 1024 + c0, v); } };
    auto PR = [&](int s_, const PSet& t, bool pred) { const int r = r0 + 2 * s_ * S; ROW(r, t.a, t, pred); ROW(r + S, t.b, t, pred); };
    auto OPQ = [&](PSet& t) { opq(t.a); opq(t.b); opq(t.sh); opq(t.sc); };
    const bool exact = T % (2 * S) == 0; const int ns = (T - r0 + 2 * S - 1) / (2 * S);
    ROWPASS_RUN(ns, exact);
}
__device__ __forceinline__ void p_norm2(const Frame& F0, int l) {
    const Frame F = phase_frame(F0);
    KParams& P = *F.p; const int c0 = F.lane * 8, S = F.G * 8; const int nrows = l == 0 ? T : TX;
    const bf16_t* XS = (const bf16_t*)(F.ws + WS_XS);
    struct PSet { R16 a, b; F16 sh, sc; };
    const int r0 = F.vcu * 8 + F.wave;
    float gg[16]; ld16f(P.in[I_N2G] + l * 1024 + c0, gg);
    auto LD = [&](int s_) -> PSet { int ra = r0 + 2 * s_ * S, rb = ra + S; ra = ra < nrows ? ra : r0; rb = rb < nrows ? rb : r0; const int bb = row_batch(ra); PSet t;
        t.a = ldr16b(XS + (size_t)ra * 1024 + c0); t.b = ldr16b(XS + (size_t)rb * 1024 + c0); t.sh = ldr16f(F.mod(l, bb, 3) + c0); t.sc = ldr16f(F.mod(l, bb, 4) + c0); return t; };
    auto ROW = [&](int r, const R16& raw, const PSet& t, bool pred) { if (!pred || r < nrows) { float v[16], sh[16], sc[16]; unp16b(raw, v); unp16f(t.sh, sh); unp16f(t.sc, sc); norm_mod16p(v, gg, sh, sc);
        st16b((bf16_t*)(F.ws + WS_HX) + (size_t)r * 1024 + c0, v);
        st16f8((unsigned char*)(F.ws + WS_HX8) + (size_t)r * 1024 + c0, v); } };
    auto PR = [&](int s_, const PSet& t, bool pred) { const int r = r0 + 2 * s_ * S; ROW(r, t.a, t, pred); ROW(r + S, t.b, t, pred); };
    auto OPQ = [&](PSet& t) { opq(t.a); opq(t.b); opq(t.sh); opq(t.sc); };
    const bool exact = nrows % (2 * S) == 0; const int ns = (nrows - r0 + 2 * S - 1) / (2 * S);
    ROWPASS_RUN(ns, exact);
}
template <bool L0> __device__ __forceinline__ void p_combine_t(const Frame& F0) {
    const Frame F = phase_frame(F0);
    KParams& P = *F.p; constexpr int l = L0 ? 0 : 1;
    const int c0 = F.lane * 8, S = F.G * 8; constexpr int nrows = L0 ? T : TX;
    const bf16_t* XS = (const bf16_t*)(F.ws + WS_XS); const bf16_t* YS = (const bf16_t*)(F.ws + WS_YS2);
    struct PSet { R16 x, y0, y1; F16 gt, sh, sc; };
    const int r0 = F.vcu * 8 + F.wave;
    float gg[16]; ld16f((L0 ? P.in[I_N1G] + 1024 : P.in[I_FING]) + c0, gg);
    auto LD = [&](int s_) -> PSet { int r = r0 + s_ * S; r = r < nrows ? r : r0; const int bb = row_batch(r); PSet t;
        t.x = ldr16b(XS + (size_t)r * 1024 + c0); t.y0 = ldr16b(YS + (size_t)(2 * r) * 1024 + c0); t.y1 = ldr16b(YS + (size_t)(2 * r + 1) * 1024 + c0); t.gt = ldr16f(F.mod(l, bb, 5) + c0);
        if constexpr (L0) { t.sh = ldr16f(F.mod(1, bb, 0) + c0); t.sc = ldr16f(F.mod(1, bb, 1) + c0); }
        return t; };
    auto PR = [&](int s_, const PSet& t, bool pred) { const int row = r0 + s_ * S; if (!pred || row < nrows) {
        float v[16], y0[16], y1[16], gt[16];
        unp16f(t.gt, gt); unp16b(t.x, v); unp16b(t.y0, y0); unp16b(t.y1, y1);
#pragma unroll
        for (int i = 0; i < 16; ++i) v[i] += gt[i] * (y0[i] + y1[i]);
        if constexpr (L0) {
            st16b((bf16_t*)(F.ws + WS_XS) + (size_t)row * 1024 + c0, v);
            float sh[16], sc[16]; unp16f(t.sh, sh); unp16f(t.sc, sc);
            norm_mod16p(v, gg, sh, sc);
            st16b((bf16_t*)(F.ws + WS_HX) + (size_t)row * 1024 + c0, v);
            st16f8((unsigned char*)(F.ws + WS_HX8) + (size_t)row * 1024 + c0, v);
        } else {
            float s = 0.f;
#pragma unroll
            for (int i = 0; i < 16; ++i) s += v[i] * v[i];
            s = wave_sum(s);
            const float rstd = rsqrtf(s * (1.0f / 1024.0f) + EPS);
            float* o = P.out + (size_t)row * 1024 + c0;
            *(f32x4*)o = (f32x4){v[0] * rstd * gg[0], v[1] * rstd * gg[1], v[2] * rstd * gg[2], v[3] * rstd * gg[3]};
            *(f32x4*)(o + 4) = (f32x4){v[4] * rstd * gg[4], v[5] * rstd * gg[5], v[6] * rstd * gg[6], v[7] * rstd * gg[7]};
            *(f32x4*)(o + 512) = (f32x4){v[8] * rstd * gg[8], v[9] * rstd * gg[9], v[10] * rstd * gg[10], v[11] * rstd * gg[11]};
            *(f32x4*)(o + 516) = (f32x4){v[12] * rstd * gg[12], v[13] * rstd * gg[13], v[14] * rstd * gg[14], v[15] * rstd * gg[15]};
        } } };
    auto OPQ = [&](PSet& t) { opq(t.x); opq(t.y0); opq(t.y1); opq(t.gt); if constexpr (L0) { opq(t.sh); opq(t.sc); } };
    const bool exact = nrows % S == 0; const int ns = (nrows - r0 + S - 1) / S;
    ROWPASS_RUN(ns, exact);
}
__device__ __forceinline__ void p_combine(const Frame& F0, int l) { if (l == 0) p_combine_t<true>(F0); else p_combine_t<false>(F0); }

__device__ __forceinline__ bf16x8 ldg8(const bf16_t* p) { return *(const bf16x8*)p; }
__device__ __forceinline__ float gmax4(float v) {
    auto r = __builtin_amdgcn_permlane32_swap(__float_as_uint(v), __float_as_uint(v), false, false); v = fmaxf(__uint_as_float(r[0]), __uint_as_float(r[1]));
    auto q = __builtin_amdgcn_permlane16_swap(__float_as_uint(v), __float_as_uint(v), false, false); return fmaxf(__uint_as_float(q[0]), __uint_as_float(q[1]));
}
__device__ __forceinline__ float gsum4(float v) {
    auto r = __builtin_amdgcn_permlane32_swap(__float_as_uint(v), __float_as_uint(v), false, false); v = __uint_as_float(r[0]) + __uint_as_float(r[1]);
    auto q = __builtin_amdgcn_permlane16_swap(__float_as_uint(v), __float_as_uint(v), false, false); return __uint_as_float(q[0]) + __uint_as_float(q[1]);
}
#define MFMA16(a, b, c) __builtin_amdgcn_mfma_f32_16x16x32_bf16(a, b, c, 0, 0, 0)

constexpr float LOG2E = 1.4426950408889634f, QSCALE = 0.125f * LOG2E;
struct AttState { float m, l; f32x4 o[4]; };
__device__ __forceinline__ void att_init(AttState& s) { s.m = -1e30f; s.l = 0.f;
#pragma unroll
    for (int d = 0; d < 4; ++d) s.o[d] = (f32x4){0.f, 0.f, 0.f, 0.f}; }
__device__ __forceinline__ void att_step(AttState& s, const float (&sc)[8], const bf16x8 (&vf)[4]) {
    float cm = sc[0];
#pragma unroll
    for (int e = 1; e < 8; ++e) cm = fmaxf(cm, sc[e]);
    cm = gmax4(cm);
    const float mn = fmaxf(s.m, cm), al = __builtin_amdgcn_exp2f(s.m - mn);
    float p[8], ps = 0.f;
#pragma unroll
    for (int e = 0; e < 8; ++e) { p[e] = __builtin_amdgcn_exp2f(sc[e] - mn); ps += p[e]; }
    s.m = mn; s.l = s.l * al + ps;
    union { bf16x8 v; unsigned u[4]; } pf;
    pf.u[0] = cvt_pk_bf16(p[0], p[1]); pf.u[1] = cvt_pk_bf16(p[2], p[3]); pf.u[2] = cvt_pk_bf16(p[4], p[5]); pf.u[3] = cvt_pk_bf16(p[6], p[7]);
#pragma unroll
    for (int d = 0; d < 4; ++d) { s.o[d] = s.o[d] * al; s.o[d] = MFMA16(vf[d], pf.v, s.o[d]); }
}

__device__ __forceinline__ void att_step2(AttState& s, const float (&sc)[16], const bf16x8 (&vf)[8]) {
    float cm = sc[0];
#pragma unroll
    for (int e = 1; e < 16; ++e) cm = fmaxf(cm, sc[e]);
    cm = gmax4(cm);
    const float mn = fmaxf(s.m, cm), al = __builtin_amdgcn_exp2f(s.m - mn);
    float p[16], ps = 0.f;
#pragma unroll
    for (int e = 0; e < 16; ++e) { p[e] = __builtin_amdgcn_exp2f(sc[e] - mn); ps += p[e]; }
    s.m = mn; s.l = s.l * al + ps;
    union { bf16x8 v; unsigned u[4]; } pa, pb;
    pa.u[0] = cvt_pk_bf16(p[0], p[1]); pa.u[1] = cvt_pk_bf16(p[2], p[3]); pa.u[2] = cvt_pk_bf16(p[4], p[5]); pa.u[3] = cvt_pk_bf16(p[6], p[7]);
    pb.u[0] = cvt_pk_bf16(p[8], p[9]); pb.u[1] = cvt_pk_bf16(p[10], p[11]); pb.u[2] = cvt_pk_bf16(p[12], p[13]); pb.u[3] = cvt_pk_bf16(p[14], p[15]);
#pragma unroll
    for (int d = 0; d < 4; ++d) { s.o[d] = s.o[d] * al; s.o[d] = MFMA16(vf[d], pa.v, s.o[d]); s.o[d] = MFMA16(vf[4 + d], pb.v, s.o[d]); }
}

__device__ __forceinline__ void na_unit_z(const Frame& F, int b, int h, int jb) {
    const int lane = F.lane, q = lane & 15, g = lane >> 4;
    bf16_t* Qa = (bf16_t*)(F.ws + WS_QA); const bf16_t* Ka = (const bf16_t*)(F.ws + WS_KA); const bf16_t* VzT = (const bf16_t*)(F.ws + WS_VAT) + (size_t)NB * 512 * SEQ;
    const size_t zrow = (size_t)TX + b * LC, qrow = zrow + 16 * jb + q;
    bf16x8 qf[2];
    qf[0] = ldg8(Qa + qrow * 512 + h * 64 + g * 8); qf[1] = ldg8(Qa + qrow * 512 + h * 64 + 32 + g * 8);
    const int kc0 = 8 * (q >> 2) + (q & 3);
    AttState st; att_init(st);
#pragma unroll 4
    for (int cc = 0; cc < 8; ++cc) {
        bf16x8 kf[2][2], vf[4];
#pragma unroll
        for (int t = 0; t < 2; ++t)
#pragma unroll
            for (int ds = 0; ds < 2; ++ds) kf[t][ds] = ldg8(Ka + (zrow + 32 * cc + kc0 + 4 * t) * 512 + h * 64 + ds * 32 + g * 8);
#pragma unroll
        for (int d = 0; d < 4; ++d) vf[d] = ldg8(VzT + ((size_t)(b * 512 + h * 64 + 16 * d + q)) * LC + 32 * cc + 8 * g);
        f32x4 s0 = (f32x4){0.f, 0.f, 0.f, 0.f}, s1 = s0;
        s0 = MFMA16(kf[0][0], qf[0], s0); s0 = MFMA16(kf[0][1], qf[1], s0);
        s1 = MFMA16(kf[1][0], qf[0], s1); s1 = MFMA16(kf[1][1], qf[1], s1);
        float sc[8];
#pragma unroll
        for (int e = 0; e < 8; ++e) sc[e] = (e < 4 ? s0[e] : s1[e - 4]) * QSCALE;
        att_step(st, sc, vf);
    }
    const float inv = 1.0f / gsum4(st.l);
#pragma unroll
    for (int d = 0; d < 4; ++d) { u32x2 w; w.x = cvt_pk_bf16(st.o[d][0] * inv, st.o[d][1] * inv); w.y = cvt_pk_bf16(st.o[d][2] * inv, st.o[d][3] * inv);
        *(u32x2*)(Qa + qrow * 512 + h * 64 + 16 * d + 4 * g) = w; }
}
template <bool ZQ> __device__ __forceinline__ void swa_unit(const Frame& F, int l, int b, int kvh, int tb) {
    KParams& P = *F.p;
    const int lane = F.lane, q = lane & 15, g = lane >> 4;
    bf16_t* Qc = (bf16_t*)(F.ws + WS_QC); const bf16_t* Kc = (const bf16_t*)(F.dq + DO_KC); const bf16_t* VcT = (const bf16_t*)(F.dq + DO_VCT);
    const size_t zrow = (size_t)TX + b * LC;
    const int t0 = 16 * tb, tq = t0 + q;
    const size_t qrow = ZQ ? zrow + tq : (size_t)b * SEQ + tq;
    bf16x8 qf[4][2];
#pragma unroll
    for (int hq = 0; hq < 4; ++hq) { qf[hq][0] = ldg8(Qc + qrow * 512 + (4 * kvh + hq) * 64 + g * 8); qf[hq][1] = ldg8(Qc + qrow * 512 + (4 * kvh + hq) * 64 + 32 + g * 8); }
    const int kc0 = 8 * (q >> 2) + (q & 3);
    AttState st[4];
#pragma unroll
    for (int hq = 0; hq < 4; ++hq) att_init(st[hq]);
    if (!ZQ) {
        for (int c = 0; c < 9; ++c) {
            const int ks = t0 - 128 + 32 * c;
            if (ks + 32 <= 0 || ks >= SEQ) continue;
            bf16x8 kf[2][2], vf[4];
#pragma unroll
            for (int t = 0; t < 2; ++t) { const int tk = min(max(ks + kc0 + 4 * t, 0), SEQ - 1);
#pragma unroll
                for (int ds = 0; ds < 2; ++ds) kf[t][ds] = ldg8(Kc + ((size_t)b * SEQ + tk) * 128 + kvh * 64 + ds * 32 + g * 8); }
            { int kg = ks + 8 * g; if (kg < 0 || kg >= SEQ) kg = 0;
#pragma unroll
              for (int d = 0; d < 4; ++d) vf[d] = ldg8(VcT + ((size_t)(b * 128 + kvh * 64 + 16 * d + q)) * SEQ + kg); }
#pragma unroll
            for (int hq = 0; hq < 4; ++hq) {
                f32x4 s0 = (f32x4){0.f, 0.f, 0.f, 0.f}, s1 = s0;
                s0 = MFMA16(kf[0][0], qf[hq][0], s0); s0 = MFMA16(kf[0][1], qf[hq][1], s0);
                s1 = MFMA16(kf[1][0], qf[hq][0], s1); s1 = MFMA16(kf[1][1], qf[hq][1], s1);
                float sc[8];
#pragma unroll
                for (int e = 0; e < 8; ++e) { const int tk = ks + 8 * g + e; const int dd = tq - tk; const bool ok = (dd <= 128) && (dd >= -128) && (tk >= 0) && (tk < SEQ);
                    sc[e] = ok ? (e < 4 ? s0[e] : s1[e - 4]) * QSCALE : -INFINITY; }
                att_step(st[hq], sc, vf);
            }
        }
    }
    const bf16_t* VzT = VcT + (size_t)NB * 128 * SEQ;
#pragma unroll 2
    for (int cc = 0; cc < 8; ++cc) {
        bf16x8 kf[2][2], vf[4];
#pragma unroll
        for (int t = 0; t < 2; ++t)
#pragma unroll
            for (int ds = 0; ds < 2; ++ds) kf[t][ds] = ldg8(Kc + (zrow + 32 * cc + kc0 + 4 * t) * 128 + kvh * 64 + ds * 32 + g * 8);
#pragma unroll
        for (int d = 0; d < 4; ++d) vf[d] = ldg8(VzT + ((size_t)(b * 128 + kvh * 64 + 16 * d + q)) * LC + 32 * cc + 8 * g);
#pragma unroll
        for (int hq = 0; hq < 4; ++hq) {
            f32x4 s0 = (f32x4){0.f, 0.f, 0.f, 0.f}, s1 = s0;
            s0 = MFMA16(kf[0][0], qf[hq][0], s0); s0 = MFMA16(kf[0][1], qf[hq][1], s0);
            s1 = MFMA16(kf[1][0], qf[hq][0], s1); s1 = MFMA16(kf[1][1], qf[hq][1], s1);
            float sc[8];
#pragma unroll
            for (int e = 0; e < 8; ++e) sc[e] = (e < 4 ? s0[e] : s1[e - 4]) * QSCALE;
            att_step(st[hq], sc, vf);
        }
    }
    const f32x4 sk4 = *(const f32x4*)(P.in[I_SINK] + l * 8 + 4 * kvh);
#pragma unroll
    for (int hq = 0; hq < 4; ++hq) {
        const float sk = sk4[hq];
        const float inv = 1.0f / (gsum4(st[hq].l) + __builtin_amdgcn_exp2f(sk * LOG2E - st[hq].m));
#pragma unroll
        for (int d = 0; d < 4; ++d) { u32x2 w; w.x = cvt_pk_bf16(st[hq].o[d][0] * inv, st[hq].o[d][1] * inv); w.y = cvt_pk_bf16(st[hq].o[d][2] * inv, st[hq].o[d][3] * inv);
            *(u32x2*)(Qc + qrow * 512 + (4 * kvh + hq) * 64 + 16 * d + 4 * g) = w; }
    }
}
__device__ __forceinline__ void pool_acc(const u32x4& w, float (&a)[8], float sgn) {
    a[0] += sgn * bf_lo(w.x); a[1] += sgn * bf_hi(w.x); a[2] += sgn * bf_lo(w.y); a[3] += sgn * bf_hi(w.y); a[4] += sgn * bf_lo(w.z); a[5] += sgn * bf_hi(w.z); a[6] += sgn * bf_lo(w.w); a[7] += sgn * bf_hi(w.w);
}
__device__ __forceinline__ void pool_run(const Frame& F, size_t rowbase, int s0, int n, int L) {
    const bf16_t* U = (const bf16_t*)(F.ws + WS_UB) + rowbase * 512 + F.lane * 8; bf16_t* Y = (bf16_t*)(F.ws + WS_YB) + rowbase * 512 + F.lane * 8;
    const int hw = 1 << (F.lane >> 4);
    float a[8];
#pragma unroll
    for (int e = 0; e < 8; ++e) a[e] = 0.f;
    { u32x4 wq[16];
#pragma unroll
      for (int k = 0; k < 16; ++k) wq[k] = *(const u32x4*)(U + (size_t)min(max(s0 - 8 + k, 0), L - 1) * 512);
#pragma unroll
      for (int k = 0; k < 16; ++k) { const int tt = s0 - 8 + k; pool_acc(wq[k], a, (tt >= s0 - hw && tt < s0 + hw && tt >= 0 && tt < L) ? 1.0f : 0.0f); } }
    for (int i0 = 0; i0 < n; i0 += 4) {
        u32x4 wc[4], wp[4], wm[4];
#pragma unroll
        for (int j = 0; j < 4; ++j) { const int s = min(s0 + i0 + j, L - 1);
            wc[j] = *(const u32x4*)(U + (size_t)s * 512); wp[j] = *(const u32x4*)(U + (size_t)min(s + hw, L - 1) * 512); wm[j] = *(const u32x4*)(U + (size_t)max(s - hw, 0) * 512); }
#pragma unroll
        for (int j = 0; j < 4; ++j) {
            const int s = s0 + i0 + j;
            if (i0 + j < n) {
                const int lo = max(s - hw, 0), hi = min(s + hw, L);
                const float inv = 1.0f / (float)(hi - lo);
                const u32x4 w = wc[j];
                u32x4 o;
                o.x = cvt_pk_bf16(a[0] * inv - bf_lo(w.x), a[1] * inv - bf_hi(w.x)); o.y = cvt_pk_bf16(a[2] * inv - bf_lo(w.y), a[3] * inv - bf_hi(w.y));
                o.z = cvt_pk_bf16(a[4] * inv - bf_lo(w.z), a[5] * inv - bf_hi(w.z)); o.w = cvt_pk_bf16(a[6] * inv - bf_lo(w.w), a[7] * inv - bf_hi(w.w));
                *(u32x4*)(Y + (size_t)s * 512) = o;
                pool_acc(wp[j], a, s + hw < L ? 1.0f : 0.0f);
                pool_acc(wm[j], a, s - hw >= 0 ? -1.0f : 0.0f);
            }
        }
    }
}
__device__ __forceinline__ void pool_run32(const Frame& F, size_t rowbase, int s0, int L) {
    const bf16_t* U = (const bf16_t*)(F.ws + WS_UB) + rowbase * 512 + F.lane * 8; bf16_t* Y = (bf16_t*)(F.ws + WS_YB) + rowbase * 512 + F.lane * 8;
    const int hw = 1 << (F.lane >> 4);
    struct PSet { u32x4 wc[4], wp[4], wm[4]; };
    auto LD = [&](int g) -> PSet { PSet t;
#pragma unroll
        for (int j = 0; j < 4; ++j) { const int s = min(s0 + 4 * g + j, L - 1);
            t.wc[j] = *(const u32x4*)(U + (size_t)s * 512); t.wp[j] = *(const u32x4*)(U + (size_t)min(s + hw, L - 1) * 512); t.wm[j] = *(const u32x4*)(U + (size_t)max(s - hw, 0) * 512); }
        return t; };
    float a[8];
#pragma unroll
    for (int e = 0; e < 8; ++e) a[e] = 0.f;
    u32x4 wq[16];
#pragma unroll
    for (int k = 0; k < 16; ++k) wq[k] = *(const u32x4*)(U + (size_t)min(max(s0 - 8 + k, 0), L - 1) * 512);
    PSet A = LD(0), B = LD(1);
#pragma unroll
    for (int k = 0; k < 16; k += 4) asm volatile("" : "+v"(wq[k]), "+v"(wq[k + 1]), "+v"(wq[k + 2]), "+v"(wq[k + 3]) :: "memory");
#pragma unroll
    for (int k = 0; k < 16; ++k) { const int tt = s0 - 8 + k; pool_acc(wq[k], a, (tt >= s0 - hw && tt < s0 + hw && tt >= 0 && tt < L) ? 1.0f : 0.0f); }
    auto PR = [&](int g, const PSet& t) {
#pragma unroll
        for (int j = 0; j < 4; ++j) {
            const int s = s0 + 4 * g + j;
            const int lo = max(s - hw, 0), hi = min(s + hw, L);
            const float inv = 1.0f / (float)(hi - lo);
            const u32x4 w = t.wc[j];
            u32x4 o;
            o.x = cvt_pk_bf16(a[0] * inv - bf_lo(w.x), a[1] * inv - bf_hi(w.x)); o.y = cvt_pk_bf16(a[2] * inv - bf_lo(w.y), a[3] * inv - bf_hi(w.y));
            o.z = cvt_pk_bf16(a[4] * inv - bf_lo(w.z), a[5] * inv - bf_hi(w.z)); o.w = cvt_pk_bf16(a[6] * inv - bf_lo(w.w), a[7] * inv - bf_hi(w.w));
            *(u32x4*)(Y + (size_t)s * 512) = o;
            pool_acc(t.wp[j], a, s + hw < L ? 1.0f : 0.0f);
            pool_acc(t.wm[j], a, s - hw >= 0 ? -1.0f : 0.0f);
        } };
#define POOL_SB do { asm volatile("" ::: "memory"); __builtin_amdgcn_sched_barrier(0); } while (0)
    PR(0, A); POOL_SB; A = LD(2); POOL_SB; PR(1, B); POOL_SB; B = LD(3); POOL_SB;
    PR(2, A); POOL_SB; A = LD(4); POOL_SB; PR(3, B); POOL_SB; B = LD(5); POOL_SB;
    PR(4, A); POOL_SB; A = LD(6); POOL_SB; PR(5, B); POOL_SB; B = LD(7); POOL_SB;
    PR(6, A); POOL_SB; PR(7, B);
#undef POOL_SB
}
struct TileSrc { const bf16_t* k; unsigned ks; const bf16_t* v; unsigned vs; };
__device__ __forceinline__ void tile_load(const TileSrc& s, int tid, u32x4& kr, u32x4& vr) {
    const int row = tid >> 3, c = tid & 7;
    kr = *(const u32x4*)(s.k + (size_t)row * s.ks + 8 * c); vr = *(const u32x4*)(s.v + (size_t)row * s.vs + 8 * c);
}
__device__ __forceinline__ void tile_store(LAS unsigned char* buf, int tid, const u32x4& kr, const u32x4& vr) {
    const int row = tid >> 3, c = tid & 7;
    *(LAS u32x4*)(buf + row * 128 + ((c ^ ((row & 3) | (((row >> 3) & 1) << 2))) << 4)) = kr;
    *(LAS u32x4*)(buf + 8192 + row * 128 + ((c ^ (row & 7)) << 4)) = vr;
}
__device__ __forceinline__ void tile_dma(const TileSrc& s, LAS unsigned char* buf, int lane, int w) {
    const int row = w * 8 + (lane >> 3), kc = (lane & 7) ^ ((row & 3) | (((row >> 3) & 1) << 2)), vc = (lane & 7) ^ (row & 7);
    __builtin_amdgcn_global_load_lds((const unsigned*)(s.k + (size_t)row * s.ks + 8 * kc), (LAS unsigned*)(buf + w * 1024), 16, 0, 0);
    __builtin_amdgcn_global_load_lds((const unsigned*)(s.v + (size_t)row * s.vs + 8 * vc), (LAS unsigned*)(buf + 8192 + w * 1024), 16, 0, 0);
}
#define RING_NEXT(r_) ((r_) == 2 ? 0 : (r_) + 1)
__device__ __forceinline__ bf16x8 kfrag(const LAS unsigned char* buf, int kb, int t, int ds, int q, int g) {
    const int row = kb + 8 * (q >> 2) + (q & 3) + 4 * t, c = 4 * ds + g;
    return *(const LAS bf16x8*)(buf + row * 128 + ((c ^ ((row & 3) | (((row >> 3) & 1) << 2))) << 4));
}
__device__ __forceinline__ bf16x8 vfrag(const LAS unsigned char* buf, int kb, int dt, int q, int g) {
    const int row = 16 * dt + q, c = (kb >> 3) + g;
    return *(const LAS bf16x8*)(buf + 8192 + row * 128 + ((c ^ (row & 7)) << 4));
}
struct FragOff { unsigned L0, L1, V0, V1, V3, V4; };
__device__ __forceinline__ FragOff frag_offsets(int q, int g) {
    FragOff f; const unsigned rq = 8 * (q >> 2) + (q & 3), e0 = (unsigned)(g ^ (q & 3)), pq = (q >> 2) & 1;
    f.L0 = rq * 128 + 16 * e0 + 64 * pq; f.L1 = rq * 128 + 16 * e0 + 64 * (1 - pq);
    f.V0 = 8192 + q * 128 + (((0 + g) ^ (q & 7)) << 4); f.V1 = 8192 + q * 128 + (((1 + g) ^ (q & 7)) << 4);
    f.V3 = 8192 + q * 128 + (((3 + g) ^ (q & 7)) << 4); f.V4 = 8192 + q * 128 + (((4 + g) ^ (q & 7)) << 4);
    return f;
}
#define LDSFRAG(off) (*(const LAS bf16x8*)(F.lds + (off)))
__device__ __forceinline__ void na_block(const Frame& F, int l, int b, int h, int rg, int& stepctr, const LAS float* rpb, bf16_t* Oa) {
    int tid = F.tid; asm volatile("" : "+v"(tid));
    const int lane = tid & 63, q = lane & 15, g = lane >> 4, w = F.wave;
    const int j = w & 3, rb0 = 8 * rg + (w >> 2);
    bf16_t* Qa = (bf16_t*)(F.ws + WS_QA); const bf16_t* Ka = (const bf16_t*)(F.ws + WS_KA); const bf16_t* VaT = (const bf16_t*)(F.ws + WS_VAT);
    const bf16_t* VzT = VaT + (size_t)NB * 512 * SEQ;
    const int U0 = min(max(8 * rg - 4, 0), 56), U1 = min(max(8 * rg + 3, 0), 56) + 7, nlat = U1 - U0 + 1, nsteps = nlat + 4;
    const unsigned qs = 65536u + (unsigned)w * 8192u;
#define NA_SRC(s_, t_) do { if ((s_) < nlat) { const int kr_ = U0 + (s_); t_.k = Ka + ((size_t)b * SEQ + kr_ * 64) * 512 + h * 64; t_.ks = 512; t_.v = VaT + ((size_t)(b * 512 + h * 64)) * SEQ + kr_ * 64; t_.vs = SEQ; } \
        else { const int cc_ = (s_) - nlat; t_.k = Ka + ((size_t)TX + b * LC + 64 * cc_) * 512 + h * 64; t_.ks = 512; t_.v = VzT + ((size_t)(b * 512 + h * 64)) * LC + 64 * cc_; t_.vs = LC; } } while (0)
    { u32x4 qv[8];
#pragma unroll
      for (int i = 0; i < 8; ++i) { const int p = lane + 64 * i, row = p >> 3, c = p & 7; const int tok = (rb0 + 2 * (row >> 4)) * 64 + 16 * j + (row & 15);
          qv[i] = *(const u32x4*)(Qa + ((size_t)b * SEQ + tok) * 512 + h * 64 + 8 * c); }
      asm volatile("" ::: "memory");
      { TileSrc ts; NA_SRC(0, ts); tile_dma(ts, F.lds + stepctr * 16384, lane, w); NA_SRC(1, ts); tile_dma(ts, F.lds + RING_NEXT(stepctr) * 16384, lane, w); }
      asm volatile("" ::: "memory");
#pragma unroll
      for (int i = 0; i < 8; ++i) { const int p = lane + 64 * i, row = p >> 3, c = p & 7;
          *(LAS u32x4*)(F.lds + qs + row * 128 + ((c ^ (row & 7)) << 4)) = qv[i]; } }
    unsigned q0o = qs + q * 128 + ((g ^ (q & 7)) << 4);
    AttState st[4];
#pragma unroll
    for (int i = 0; i < 4; ++i) att_init(st[i]);
    const int band0 = j == 0 ? 0 : j == 1 ? 8 : j == 2 ? 24 : 32; const bool odd = (j == 1 || j == 2);
    const FragOff fo = frag_offsets(q, g);
    unsigned kA = (odd ? fo.L1 : fo.L0) + band0 * 128, kB = (odd ? fo.L0 : fo.L1) + band0 * 128;
    unsigned vJ = 8192u + q * 128 + ((((band0 >> 3) + g) ^ (q & 7)) << 4);
    unsigned cL0 = fo.L0, cL1 = fo.L1, cV0 = fo.V0, cV4 = fo.V4;
    int cj; unsigned mk;
    { const int qc = 16 * j + q, wstart = min(max(qc - 8, 0), 48); cj = band0 + 8 * g - qc + 15; unsigned m = 0;
#pragma unroll
      for (int e = 0; e < 8; ++e) { const int kc = band0 + 8 * g + e; m |= ((kc >= wstart) && (kc < wstart + 16)) ? (1u << e) : 0u; }
      mk = m; }
    for (int s = 0; s < nsteps; ++s) {
        const unsigned bo = (unsigned)stepctr * 16384u; const int r1 = RING_NEXT(stepctr), r2 = RING_NEXT(r1); stepctr = r1;
        if (s + 1 < nsteps) asm volatile("s_waitcnt vmcnt(2) lgkmcnt(0)" ::: "memory"); else asm volatile("s_waitcnt vmcnt(0) lgkmcnt(0)" ::: "memory");
        __builtin_amdgcn_s_barrier();
        asm volatile("" ::: "memory");
        if (s + 2 < nsteps) { TileSrc ts; NA_SRC(s + 2, ts); tile_dma(ts, F.lds + r2 * 16384, lane, w); }
        asm volatile("" : "+v"(kA), "+v"(kB), "+v"(vJ), "+v"(cL0), "+v"(cL1), "+v"(cV0), "+v"(cV4), "+v"(q0o), "+v"(cj), "+v"(mk));
        if (s < nlat) {
            const int kr = U0 + s;
            bool act[4]; bool any = false;
#pragma unroll
            for (int i = 0; i < 4; ++i) { const int r = rb0 + 2 * i, r0 = min(max(r - 4, 0), 56); act[i] = (kr >= r0 && kr <= r0 + 7); any = any || act[i]; }
            if (any) {
                bf16x8 vf[4];
                const bf16x8 k00 = LDSFRAG(kA + bo), k01 = LDSFRAG(kB + bo), k10 = LDSFRAG(kA + bo + 512), k11 = LDSFRAG(kB + bo + 512);
#pragma unroll
                for (int d = 0; d < 4; ++d) vf[d] = LDSFRAG(vJ + bo + d * 2048);
#pragma unroll
                for (int i = 0; i < 4; ++i) {
                    if (act[i]) {
                        const LAS float* rb = rpb + (kr - (rb0 + 2 * i) + 7) * 31;
                        f32x4 s0 = (f32x4){0.f, 0.f, 0.f, 0.f}, s1 = s0;
                        const bf16x8 qa = LDSFRAG(q0o + i * 2048), qb = LDSFRAG((q0o ^ 64u) + i * 2048);
                        s0 = MFMA16(k00, qa, s0); s0 = MFMA16(k01, qb, s0);
                        s1 = MFMA16(k10, qa, s1); s1 = MFMA16(k11, qb, s1);
                        float sc[8], bias[8];
#pragma unroll
                        for (int e = 0; e < 8; ++e) bias[e] = rb[cj + e];
#pragma unroll
                        for (int e = 0; e < 8; ++e) { const float t = __builtin_fmaf(e < 4 ? s0[e] : s1[e - 4], QSCALE, bias[e]);
                            sc[e] = ((mk >> e) & 1u) ? t : -INFINITY; }
                        att_step(st[i], sc, vf);
                    }
                }
            }
        } else {
            const unsigned l0 = cL0 + bo, l1 = cL1 + bo;
            bf16x8 vf[8];
            const bf16x8 k00 = LDSFRAG(l0), k01 = LDSFRAG(l1), k10 = LDSFRAG(l0 + 512), k11 = LDSFRAG(l1 + 512);
            const bf16x8 h00 = LDSFRAG(l0 + 4096), h01 = LDSFRAG(l1 + 4096), h10 = LDSFRAG(l0 + 4096 + 512), h11 = LDSFRAG(l1 + 4096 + 512);
#pragma unroll
            for (int d = 0; d < 4; ++d) { vf[d] = LDSFRAG(cV0 + bo + d * 2048); vf[4 + d] = LDSFRAG(cV4 + bo + d * 2048); }
#pragma unroll
            for (int i = 0; i < 4; ++i) {
                f32x4 s0 = (f32x4){0.f, 0.f, 0.f, 0.f}, s1 = s0, t0 = s0, t1 = s0;
                const bf16x8 qa = LDSFRAG(q0o + i * 2048), qb = LDSFRAG((q0o ^ 64u) + i * 2048);
                s0 = MFMA16(k00, qa, s0); s0 = MFMA16(k01, qb, s0);
                s1 = MFMA16(k10, qa, s1); s1 = MFMA16(k11, qb, s1);
                t0 = MFMA16(h00, qa, t0); t0 = MFMA16(h01, qb, t0);
                t1 = MFMA16(h10, qa, t1); t1 = MFMA16(h11, qb, t1);
                float sc[16];
#pragma unroll
                for (int e = 0; e < 4; ++e) { sc[e] = s0[e] * QSCALE; sc[4 + e] = s1[e] * QSCALE; sc[8 + e] = t0[e] * QSCALE; sc[12 + e] = t1[e] * QSCALE; }
                att_step2(st[i], sc, vf);
            }
        }
    }
#pragma unroll
    for (int i = 0; i < 4; ++i) { const float inv = 1.0f / gsum4(st[i].l); const size_t orow = (size_t)b * SEQ + (rb0 + 2 * i) * 64 + 16 * j + q;
#pragma unroll
        for (int d = 0; d < 4; ++d) { u32x2 wv; wv.x = cvt_pk_bf16(st[i].o[d][0] * inv, st[i].o[d][1] * inv); wv.y = cvt_pk_bf16(st[i].o[d][2] * inv, st[i].o[d][3] * inv);
            *(u32x2*)(Oa + orow * 512 + h * 64 + 16 * d + 4 * g) = wv; } }
}
__device__ __forceinline__ void swa_block(const Frame& F, int l, int b, int kvh, int qb, int& stepctr, bf16_t* Oc) {
    KParams& P = *F.p;
    int tid = F.tid; asm volatile("" : "+v"(tid));
    const int lane = tid & 63, q = lane & 15, g = lane >> 4, w = F.wave;
    bf16_t* Qc = (bf16_t*)(F.ws + WS_QC); const bf16_t* Kc = (const bf16_t*)(F.dq + DO_KC); const bf16_t* VcT = (const bf16_t*)(F.dq + DO_VCT);
    const bf16_t* VzT = VcT + (size_t)NB * 128 * SEQ;
    const int q0 = 128 * qb, t0 = q0 + 16 * w, tq = t0 + q;
    const size_t qrow = (size_t)b * SEQ + tq;
    bf16x8 qf[4][2];
#pragma unroll
    for (int hq = 0; hq < 4; ++hq) { qf[hq][0] = ldg8(Qc + qrow * 512 + (4 * kvh + hq) * 64 + g * 8); qf[hq][1] = ldg8(Qc + qrow * 512 + (4 * kvh + hq) * 64 + 32 + g * 8); }
    AttState st[4];
#pragma unroll
    for (int hq = 0; hq < 4; ++hq) att_init(st[hq]);
    const int s_lo = q0 == 0 ? 2 : 0, s_hi = min(6, (SEQ - q0 + 128) / 64), nwin = s_hi - s_lo, nsteps = nwin + 4;
#define SWA_SRC(s_, t_) do { if ((s_) < nwin) { const int key0_ = q0 - 128 + 64 * (s_lo + (s_)); t_.k = Kc + ((size_t)b * SEQ + key0_) * 128 + kvh * 64; t_.ks = 128; t_.v = VcT + ((size_t)(b * 128 + kvh * 64)) * SEQ + key0_; t_.vs = SEQ; } \
        else { const int cc_ = (s_) - nwin; t_.k = Kc + ((size_t)TX + b * LC + 64 * cc_) * 128 + kvh * 64; t_.ks = 128; t_.v = VzT + ((size_t)(b * 128 + kvh * 64)) * LC + 64 * cc_; t_.vs = LC; } } while (0)
    { TileSrc ts; SWA_SRC(0, ts); tile_dma(ts, F.lds + stepctr * 16384, lane, w); SWA_SRC(1, ts); tile_dma(ts, F.lds + RING_NEXT(stepctr) * 16384, lane, w); }
    for (int s = 0; s < nsteps; ++s) {
        LAS unsigned char* buf = F.lds + stepctr * 16384; const int r1 = RING_NEXT(stepctr), r2 = RING_NEXT(r1); stepctr = r1;
        if (s + 1 < nsteps) asm volatile("s_waitcnt vmcnt(2) lgkmcnt(0)" ::: "memory"); else asm volatile("s_waitcnt vmcnt(0) lgkmcnt(0)" ::: "memory");
        __builtin_amdgcn_s_barrier();
        asm volatile("" ::: "memory");
        if (s + 2 < nsteps) { TileSrc ts; SWA_SRC(s + 2, ts); tile_dma(ts, F.lds + r2 * 16384, lane, w); }
        const bool win = s < nwin; const int key0 = q0 - 128 + 64 * (s_lo + s);
        const bool n0 = !win || !(key0 + 31 < t0 - 128 || key0 > t0 + 15 + 128), n1 = !win || !(key0 + 63 < t0 - 128 || key0 + 32 > t0 + 15 + 128);
        if (n0 && n1) {
            bf16x8 vf[8];
            const bf16x8 k00 = kfrag(buf, 0, 0, 0, q, g), k01 = kfrag(buf, 0, 0, 1, q, g), k10 = kfrag(buf, 0, 1, 0, q, g), k11 = kfrag(buf, 0, 1, 1, q, g);
            const bf16x8 h00 = kfrag(buf, 32, 0, 0, q, g), h01 = kfrag(buf, 32, 0, 1, q, g), h10 = kfrag(buf, 32, 1, 0, q, g), h11 = kfrag(buf, 32, 1, 1, q, g);
#pragma unroll
            for (int d = 0; d < 4; ++d) { vf[d] = vfrag(buf, 0, d, q, g); vf[4 + d] = vfrag(buf, 32, d, q, g); }
#pragma unroll
            for (int hq = 0; hq < 4; ++hq) {
                f32x4 s0 = (f32x4){0.f, 0.f, 0.f, 0.f}, s1 = s0, u0 = s0, u1 = s0;
                s0 = MFMA16(k00, qf[hq][0], s0); s0 = MFMA16(k01, qf[hq][1], s0);
                s1 = MFMA16(k10, qf[hq][0], s1); s1 = MFMA16(k11, qf[hq][1], s1);
                u0 = MFMA16(h00, qf[hq][0], u0); u0 = MFMA16(h01, qf[hq][1], u0);
                u1 = MFMA16(h10, qf[hq][0], u1); u1 = MFMA16(h11, qf[hq][1], u1);
                float sc[16];
#pragma unroll
                for (int e = 0; e < 8; ++e) { const int dd = tq - (key0 + 8 * g + e); const bool ok0 = !win || ((dd <= 128) && (dd >= -128)), ok1 = !win || ((dd - 32 <= 128) && (dd - 32 >= -128));
                    sc[e] = ok0 ? (e < 4 ? s0[e] : s1[e - 4]) * QSCALE : -INFINITY; sc[8 + e] = ok1 ? (e < 4 ? u0[e] : u1[e - 4]) * QSCALE : -INFINITY; }
                att_step2(st[hq], sc, vf);
            }
        } else if (n0 || n1) {
            const int kb = n0 ? 0 : 32, ks = key0 + kb;
            bf16x8 vf[4];
            const bf16x8 k00 = kfrag(buf, kb, 0, 0, q, g), k01 = kfrag(buf, kb, 0, 1, q, g), k10 = kfrag(buf, kb, 1, 0, q, g), k11 = kfrag(buf, kb, 1, 1, q, g);
#pragma unroll
            for (int d = 0; d < 4; ++d) vf[d] = vfrag(buf, kb, d, q, g);
#pragma unroll
            for (int hq = 0; hq < 4; ++hq) {
                f32x4 s0 = (f32x4){0.f, 0.f, 0.f, 0.f}, s1 = s0;
                s0 = MFMA16(k00, qf[hq][0], s0); s0 = MFMA16(k01, qf[hq][1], s0);
                s1 = MFMA16(k10, qf[hq][0], s1); s1 = MFMA16(k11, qf[hq][1], s1);
                float sc[8];
#pragma unroll
                for (int e = 0; e < 8; ++e) { const int dd = tq - (ks + 8 * g + e); const bool ok = !win || ((dd <= 128) && (dd >= -128));
                    sc[e] = ok ? (e < 4 ? s0[e] : s1[e - 4]) * QSCALE : -INFINITY; }
                att_step(st[hq], sc, vf);
            }
        }
    }
    const f32x4 sk4 = *(const f32x4*)(P.in[I_SINK] + l * 8 + 4 * kvh);
#pragma unroll
    for (int hq = 0; hq < 4; ++hq) {
        const float sk = sk4[hq];
        const float inv = 1.0f / (gsum4(st[hq].l) + __builtin_amdgcn_exp2f(sk * LOG2E - st[hq].m));
#pragma unroll
        for (int d = 0; d < 4; ++d) { u32x2 wv; wv.x = cvt_pk_bf16(st[hq].o[d][0] * inv, st[hq].o[d][1] * inv); wv.y = cvt_pk_bf16(st[hq].o[d][2] * inv, st[hq].o[d][3] * inv);
            *(u32x2*)(Oc + qrow * 512 + (4 * kvh + hq) * 64 + 16 * d + 4 * g) = wv; }
    }
}
__device__ __forceinline__ void p_mixers(const Frame& F0, int l) {
    const Frame F = phase_frame(F0);
    KParams& P = *F.p;
    LAS float* rpb = (LAS float*)(F.lds + 49152 + F.wave * 2048);
    int cur_h = -1, stepctr = 0;
    const bool junk = (P.flags & 1) != 0;
    bf16_t* Oa = junk ? (bf16_t*)(F.dq + DO_M) : (bf16_t*)(F.ws + WS_QA); bf16_t* Oc = junk ? (bf16_t*)(F.dq + DO_M) + (size_t)T * 512 : (bf16_t*)(F.ws + WS_QC);
    const int W = F.vcu * 8 + F.wave, nW = F.G * 8;
    const bool doA = !junk || (P.flags & 2), doC = !junk || (P.flags & 4), doB = !junk || (P.flags & 8);
    if (doA) { const int per = (1024 + F.G - 1) / F.G;
      for (int i = 0; i < per; ++i) { const int u = F.vcu * per + i; if (u >= 1024) break;
          const int rg = u & 7, h = (u >> 3) & 7, b = u >> 6;
          if (h != cur_h) { const float* rsrc = P.in[I_RPB] + (size_t)(l * 8 + h) * 465; float rv[8];
#pragma unroll
              for (int k = 0; k < 8; ++k) rv[k] = rsrc[min(F.lane + 64 * k, 464)];
#pragma unroll
              for (int k = 0; k < 8; ++k) if (F.lane + 64 * k < 465) rpb[F.lane + 64 * k] = rv[k] * LOG2E;
              cur_h = h; }
          na_block(F, l, b, h, rg, stepctr, rpb, Oa); } }
    if (doC) { const int per = (1024 + F.G - 1) / F.G;
      for (int i = 0; i < per; ++i) { const int u = F.vcu * per + i; if (u >= 1024) break;
          swa_block(F, l, u >> 6, (u >> 5) & 1, u & 31, stepctr, Oc); } }
    if (doB) for (int r = W; r < TX / 32; r += nW) pool_run32(F, (size_t)(r >> 7) * SEQ, (r & 127) * 32, SEQ);
    if (l == 0 && !junk) {
        for (int u = W; u < 2048; u += nW) na_unit_z(F, u >> 7, (u >> 4) & 7, u & 15);
        for (int u = W; u < 512; u += nW) swa_unit<true>(F, l, u >> 5, (u >> 4) & 1, u & 15);
        for (int r = W; r < TZ / 2; r += nW) pool_run(F, (size_t)TX + (size_t)(r >> 7) * LC, (r & 127) * 2, 2, LC);
    }
}

__device__ __forceinline__ u32x4 pack8(const f32x4& a, const f32x4& b) { u32x4 w; w.x = cvt_pk_bf16(a[0], a[1]); w.y = cvt_pk_bf16(a[2], a[3]); w.z = cvt_pk_bf16(b[0], b[1]); w.w = cvt_pk_bf16(b[2], b[3]); return w; }
__device__ __forceinline__ void unpack8(const u32x4& w, f32x4& a, f32x4& b) { a = (f32x4){bf_lo(w.x), bf_hi(w.x), bf_lo(w.y), bf_hi(w.y)}; b = (f32x4){bf_lo(w.z), bf_hi(w.z), bf_lo(w.w), bf_hi(w.w)}; }

struct SchedIn { const char* A; const char* B; int nM, nN, tile0, G, c;
    __device__ __forceinline__ bool next(int i, GUnit& u) const { int pm, pn; if (!gm::static_tile(i * G + c, nM, nN, pm, pn)) return false;
        u.A = A + (size_t)pm * 256 * 2048; u.B = B + (size_t)(tile0 + pn) * 256 * 2048; u.lda2 = 2048; u.ldb2 = 2048; u.nt = 16; u.rows = nullptr; u.nrows = 256; u.pm = pm; u.pn = tile0 + pn; u.a0 = 0; u.a1 = 0; return true; } };
struct EpiIn {
    static constexpr bool PERM = true;
    unsigned char* ws; unsigned char* dq;
    __device__ __forceinline__ const float* rope_ptr(int row, int wc, int fq) const { const int s = row & 4095, pos = (wc & 1) ? (s & 63) : (s >> 6); return (const float*)(ws + WS_ROPE) + (size_t)(pos * 16 + 4 * fq) * 2; }
    __device__ __forceinline__ void rope(f32x4& v0, f32x4& v1, const f32x4& t0, const f32x4& t1) const {
        const float cs[4] = {t0[0], t0[2], t1[0], t1[2]}, sn[4] = {t0[1], t0[3], t1[1], t1[3]};
#pragma unroll
        for (int j = 0; j < 4; ++j) { const float x1 = v0[j], x2 = v1[j]; v0[j] = x1 * cs[j] - x2 * sn[j]; v1[j] = x2 * cs[j] + x1 * sn[j]; }
    }
    __device__ __forceinline__ void operator()(const f32x4 (&acc)[2][2][4][2], const GUnit& u, int wr, int wc, int fr, int fq) const {
        const int tile = u.pn, pm = u.pm; const bool xrows = pm < 256;
        const bool rp = (tile == 4 || tile == 5 || tile == 10) && xrows;
        f32x4 tb[8][2];
        if (rp) {
#pragma unroll
            for (int i = 0; i < 8; ++i) { const float* tp = rope_ptr(pm * 256 + (i >> 2) * 128 + wr * 64 + (i & 3) * 16 + fr, wc, fq); tb[i][0] = *(const f32x4*)tp; tb[i][1] = *(const f32x4*)(tp + 4); }
            asm volatile("" ::: "memory");
        }
        if (tile < 6) {
            bf16_t* dst = (bf16_t*)(ws + (tile < 2 ? WS_QA : tile < 4 ? WS_UB : WS_QC)) + (tile & 1) * 256;
#pragma unroll
            for (int ai = 0; ai < 2; ++ai)
#pragma unroll
                for (int m = 0; m < 4; ++m) { const int row = pm * 256 + ai * 128 + wr * 64 + m * 16 + fr;
#pragma unroll
                    for (int bj = 0; bj < 2; ++bj) { f32x4 v0 = acc[ai][bj][m][0], v1 = acc[ai][bj][m][1]; if (rp) rope(v0, v1, tb[ai * 4 + m][0], tb[ai * 4 + m][1]);
                        *(u32x4*)(dst + (size_t)row * 512 + bj * 128 + wc * 32 + fq * 8) = pack8(v0, v1); } }
        } else {
            const int j = tile - 6;
            bf16_t* kd = j < 4 ? (bf16_t*)(ws + WS_KA) + j * 128 : (bf16_t*)(dq + DO_KC); const int ldk = j < 4 ? 512 : 128;
#pragma unroll
            for (int ai = 0; ai < 2; ++ai)
#pragma unroll
                for (int m = 0; m < 4; ++m) { const int row = pm * 256 + ai * 128 + wr * 64 + m * 16 + fr;
                    f32x4 v0 = acc[ai][0][m][0], v1 = acc[ai][0][m][1]; if (rp) rope(v0, v1, tb[ai * 4 + m][0], tb[ai * 4 + m][1]);
                    *(u32x4*)(kd + (size_t)row * ldk + wc * 32 + fq * 8) = pack8(v0, v1); }
            const int nch = j < 4 ? 512 : 128, chb = j < 4 ? 128 * j : 0;
            bf16_t* vt = j < 4 ? (bf16_t*)(ws + WS_VAT) : (bf16_t*)(dq + DO_VCT);
            size_t base; int L;
            if (xrows) { base = ((size_t)(pm >> 4) * nch) * SEQ + (size_t)(pm & 15) * 256; L = SEQ; }
            else { base = (size_t)NB * nch * SEQ + ((size_t)(pm - 256) * nch) * LC; L = LC; }
#pragma unroll
            for (int n = 0; n < 2; ++n) { const int ch = chb + wc * 32 + 8 * (fr >> 2) + 4 * n + (fr & 3);
#pragma unroll
                for (int ai = 0; ai < 2; ++ai)
#pragma unroll
                    for (int m = 0; m < 4; ++m) { const f32x4 v = acc[ai][1][m][n]; u32x2 w; w.x = cvt_pk_bf16(v[0], v[1]); w.y = cvt_pk_bf16(v[2], v[3]);
                        *(u32x2*)(vt + base + (size_t)ch * L + ai * 128 + wr * 64 + m * 16 + 4 * fq) = w; } }
        }
    }
};

struct SchedMerge { const char* HX; const char* Yb;     const char* WG; const char* WB; int nM, pm0, G, c;
    __device__ __forceinline__ bool next(int i, GUnit& u) const { int pm, pn; const int ti = i / 6, sub = i - ti * 6; if (!gm::static_tile(ti * G + c, nM, 4, pm, pn)) return false;
        pm += pm0; const int br = sub >> 1;
        if (!(sub & 1)) { u.A = HX + (size_t)pm * 256 * 1024; u.B = WG + ((size_t)br * 1024 + pn * 256) * 1024; u.lda2 = 1024; u.ldb2 = 1024; u.nt = 8; }
        else { u.A = Yb + (size_t)(br ? 3 + br : 0) * SZ_TH + (size_t)pm * 256 * 1024; u.B = WB + ((size_t)br * 1024 + pn * 256) * 1024; u.lda2 = 1024; u.ldb2 = 1024; u.nt = 8; }
        u.rows = nullptr; u.nrows = 256; u.pm = pm; u.pn = pn; u.a0 = sub; u.a1 = (sub & 1) ? 0 : 2; return true; } };
struct EpiMerge {
    static constexpr bool PERM = true;
    bf16_t* sig; bf16_t* M; unsigned char* M8;
    __device__ __forceinline__ void operator()(const f32x4 (&acc)[2][2][4][2], const GUnit& u, int wr, int wc, int fr, int fq) const {
        const int sub = u.a0; const int tid = (wr * 4 + wc) * 64 + fq * 16 + fr;
        bf16_t* sp0 = sig + (size_t)tid * 8;
        bf16_t* mp0 = M + (size_t)(u.pm * 256 + wr * 64 + fr) * 1024 + u.pn * 256 + wc * 32 + fq * 8;
        if (!(sub & 1)) {
#pragma unroll
            for (int ai = 0; ai < 2; ++ai)
#pragma unroll
                for (int m = 0; m < 4; ++m)
#pragma unroll
                    for (int bj = 0; bj < 2; ++bj) { f32x4 a = acc[ai][bj][m][0], b = acc[ai][bj][m][1];
#pragma unroll
                        for (int e = 0; e < 4; ++e) { a[e] = __builtin_amdgcn_rcpf(1.0f + __builtin_amdgcn_exp2f((-LOG2E / W8SCALE) * a[e])); b[e] = __builtin_amdgcn_rcpf(1.0f + __builtin_amdgcn_exp2f((-LOG2E / W8SCALE) * b[e])); }
                        *(u32x4*)(sp0 + (size_t)((ai * 4 + m) * 2 + bj) * 4096) = pack8(a, b); }
        } else if (sub == 1) {
            u32x4 sg[16];
#pragma unroll
            for (int i = 0; i < 16; ++i) sg[i] = *(const u32x4*)(sp0 + (size_t)i * 4096);
            asm volatile("" ::: "memory");
#pragma unroll
            for (int ai = 0; ai < 2; ++ai)
#pragma unroll
                for (int m = 0; m < 4; ++m)
#pragma unroll
                    for (int bj = 0; bj < 2; ++bj) { f32x4 ga, gb; unpack8(sg[(ai * 4 + m) * 2 + bj], ga, gb);
                        *(u32x4*)(mp0 + (size_t)(ai * 128 + m * 16) * 1024 + bj * 128) = pack8(acc[ai][bj][m][0] * ga, acc[ai][bj][m][1] * gb); }
        } else {
            u32x4 sgb[2][4], pmb[2][4];
            auto LQ = [&](int q, u32x4 (&sg)[4], u32x4 (&pm_)[4]) { const int ai = q >> 1, mh = q & 1;
#pragma unroll
                for (int i = 0; i < 4; ++i) { const int m = mh * 2 + (i >> 1), bj = i & 1; sg[i] = *(const u32x4*)(sp0 + (size_t)(ai * 8 + m * 2 + bj) * 4096); pm_[i] = *(const u32x4*)(mp0 + (size_t)(ai * 128 + m * 16) * 1024 + bj * 128); } };
            auto SQ = [&](int q, const u32x4 (&sg)[4], const u32x4 (&pm_)[4]) { const int ai = q >> 1, mh = q & 1;
#pragma unroll
                for (int i = 0; i < 4; ++i) { const int m = mh * 2 + (i >> 1), bj = i & 1; f32x4 ga, gb, pa, pb; unpack8(sg[i], ga, gb); unpack8(pm_[i], pa, pb);
                    const f32x4 ra = pa + acc[ai][bj][m][0] * ga, rb = pb + acc[ai][bj][m][1] * gb;
                    if (sub == 5) { u32x2 w8; w8.x = pk4_fp8(ra[0] * M8SCALE, ra[1] * M8SCALE, ra[2] * M8SCALE, ra[3] * M8SCALE); w8.y = pk4_fp8(rb[0] * M8SCALE, rb[1] * M8SCALE, rb[2] * M8SCALE, rb[3] * M8SCALE);
                        *(u32x2*)(M8 + (size_t)(u.pm * 256 + wr * 64 + fr + ai * 128 + m * 16) * 1024 + u.pn * 256 + wc * 32 + fq * 8 + bj * 128) = w8; }
                    else *(u32x4*)(mp0 + (size_t)(ai * 128 + m * 16) * 1024 + bj * 128) = pack8(ra, rb); } };
            LQ(0, sgb[0], pmb[0]); LQ(1, sgb[1], pmb[1]); asm volatile("" ::: "memory");
            SQ(0, sgb[0], pmb[0]); asm volatile("" ::: "memory"); LQ(2, sgb[0], pmb[0]); asm volatile("" ::: "memory");
            SQ(1, sgb[1], pmb[1]); asm volatile("" ::: "memory"); LQ(3, sgb[1], pmb[1]); asm volatile("" ::: "memory");
            SQ(2, sgb[0], pmb[0]); asm volatile("" ::: "memory"); SQ(3, sgb[1], pmb[1]); asm volatile("" ::: "memory");
        }
    }
};

struct SchedDense { const char* A; const char* B; int nM, nN, pm0, Lb, Ls, imax;
    __device__ __forceinline__ bool next(int i, GUnit& u) const { int pm, pn; if (i >= imax || !gm::static_tile(Lb + i * Ls, nM, nN, pm, pn)) return false;
        pm += pm0; u.A = A + (size_t)pm * 256 * 2048; u.B = B + (size_t)pn * 256 * 2048; u.lda2 = 2048; u.ldb2 = 2048; u.nt = 16; u.rows = nullptr; u.nrows = 256; u.pm = pm; u.pn = pn; u.a0 = 0; u.a1 = 0; return true; } };
struct SchedDense8 { const char* A; const char* B; int nM, nN, pm0, Lb, Ls, imax;
    __device__ __forceinline__ bool next(int i, GUnit& u) const { int pm, pn; if (i >= imax || !gm::static_tile(Lb + i * Ls, nM, nN, pm, pn)) return false;
        int n8 = 8; asm volatile("" : "+s"(n8));
        pm += pm0; u.A = A + (size_t)pm * 256 * 1024; u.B = B + (size_t)pn * 256 * 1024; u.lda2 = 1024; u.ldb2 = 1024; u.nt = n8; u.rows = nullptr; u.nrows = 256; u.pm = pm; u.pn = pn; u.a0 = 0; u.a1 = 2; return true; } };
struct EpiOut {
    static constexpr bool PERM = true;
    const float* xin; const float* zin; bf16_t* XS; const float* mod; int l;
    __device__ __forceinline__ void operator()(const f32x4 (&acc)[2][2][4][2], const GUnit& u, int wr, int wc, int fr, int fq) const {
        const int bb = u.pm < 256 ? (u.pm >> 4) : 16;
        const float* gt = mod + (size_t)bb * 6144 + 2 * 1024 + u.pn * 256 + wc * 32 + fq * 8;
        f32x4 g[2][2];
#pragma unroll
        for (int bj = 0; bj < 2; ++bj) { g[bj][0] = *(const f32x4*)(gt + bj * 128) * (1.0f / (W8SCALE * M8SCALE)); g[bj][1] = *(const f32x4*)(gt + bj * 128 + 4) * (1.0f / (W8SCALE * M8SCALE)); }
        const int row0 = u.pm * 256 + wr * 64 + fr, col0 = u.pn * 256 + wc * 32 + fq * 8;
        bf16_t* xp = XS + (size_t)row0 * 1024 + col0;
#define EPI_FENCE asm volatile("" ::: "memory")
        if (l == 0) {
            const float* rp = (row0 < TX ? xin + (size_t)row0 * 1024 : zin + (size_t)(row0 - TX) * 1024) + col0;
            f32x4 r[2][4][2];
            auto LQ = [&](int q, f32x4 (&buf)[4][2]) { const int ai = q >> 1, mh = q & 1;
#pragma unroll
                for (int i = 0; i < 4; ++i) { const float* p = rp + (size_t)(ai * 128 + (mh * 2 + (i >> 1)) * 16) * 1024 + (i & 1) * 128; buf[i][0] = *(const f32x4*)p; buf[i][1] = *(const f32x4*)(p + 4); } };
            auto SQ = [&](int q, const f32x4 (&buf)[4][2]) { const int ai = q >> 1, mh = q & 1;
#pragma unroll
                for (int mm = 0; mm < 2; ++mm)
#pragma unroll
                    for (int bj = 0; bj < 2; ++bj) { const int m = mh * 2 + mm; *(u32x4*)(xp + (size_t)(ai * 128 + m * 16) * 1024 + bj * 128) = pack8(buf[mm * 2 + bj][0] + g[bj][0] * acc[ai][bj][m][0], buf[mm * 2 + bj][1] + g[bj][1] * acc[ai][bj][m][1]); } };
            LQ(0, r[0]); LQ(1, r[1]); EPI_FENCE;
            SQ(0, r[0]); EPI_FENCE; LQ(2, r[0]); EPI_FENCE; SQ(1, r[1]); EPI_FENCE; LQ(3, r[1]); EPI_FENCE; SQ(2, r[0]); EPI_FENCE; SQ(3, r[1]); EPI_FENCE;
        } else {
            u32x4 r[2][8];
#pragma unroll
            for (int ai = 0; ai < 2; ++ai)
#pragma unroll
                for (int i = 0; i < 8; ++i) r[ai][i] = *(const u32x4*)(xp + (size_t)(ai * 128 + (i >> 1) * 16) * 1024 + (i & 1) * 128);
            EPI_FENCE;
#pragma unroll
            for (int ai = 0; ai < 2; ++ai) {
#pragma unroll
                for (int m = 0; m < 4; ++m)
#pragma unroll
                    for (int bj = 0; bj < 2; ++bj) { f32x4 r0, r1; unpack8(r[ai][m * 2 + bj], r0, r1);
                        *(u32x4*)(xp + (size_t)(ai * 128 + m * 16) * 1024 + bj * 128) = pack8(r0 + g[bj][0] * acc[ai][bj][m][0], r1 + g[bj][1] * acc[ai][bj][m][1]); }
                EPI_FENCE;
            }
        }
    }
};
struct EpiRouter {
    static constexpr bool PERM = true;
    float* LOG;
    __device__ __forceinline__ void operator()(const f32x4 (&acc)[2][2][4][2], const GUnit& u, int wr, int wc, int fr, int fq) const {
        if (wc >= 2) return;
#pragma unroll
        for (int ai = 0; ai < 2; ++ai)
#pragma unroll
            for (int m = 0; m < 4; ++m) { float* p = LOG + (size_t)(u.pm * 256 + ai * 128 + wr * 64 + m * 16 + fr) * 64 + wc * 32 + fq * 8;
                *(f32x4*)p = acc[ai][0][m][0]; *(f32x4*)(p + 4) = acc[ai][0][m][1]; }
    }
};
struct MoeTab { LAS int* pre; LAS int* cnt; };
__device__ __forceinline__ void moe_tables(const Frame& F0, int l, MoeTab& mt) {
    const Frame F = phase_frame(F0);
    mt.pre = (LAS int*)(F.lds + LDS_X + 64); mt.cnt = mt.pre + 40;
    __syncthreads();
    { const unsigned* cc = (const unsigned*)(F.ws + WS_CNTC) + (F.tid & 31); const int nch = (l == 0 ? T : TX) / 512, c0 = F.tid >> 5; unsigned tot = 0, vv[9];
#pragma unroll
      for (int k = 0; k < 9; ++k) vv[k] = cc[min(c0 + 16 * k, nch - 1) * 32];
#pragma unroll
      for (int k = 0; k < 9; ++k) tot += (c0 + 16 * k < nch) ? vv[k] : 0u;
      mt.pre[64 + F.tid] = (int)tot; }
    __syncthreads();
    if (F.tid < 32) { int tot = 0;
#pragma unroll
        for (int k = 0; k < 16; ++k) tot += mt.pre[64 + k * 32 + F.tid];
        mt.cnt[F.tid] = tot; }
    __syncthreads();
    if (F.tid < 64) { const int e = F.tid & 31; int s = 0, tot = 0;
#pragma unroll
        for (int k = 0; k < 32; ++k) { const int t = (mt.cnt[k] + 255) >> 8; s += (k < e) ? t : 0; tot += t; }
        if (F.tid < 32) mt.pre[e] = s;
        if (F.tid == 0) mt.pre[32] = tot; }
    __syncthreads();
}
template <bool UP> struct SchedMoe { MoeTab mt; const char* A; const char* W; const int* ltok; int G, c;
    __device__ __forceinline__ bool next(int i, GUnit& u) const {
        const int v = i * (G >> 3) + (c >> 3), tau = 8 * (v >> 2) + (c & 7), pn = v & 3; const int ntile = mt.pre[32];
        if (tau >= ntile) return false;
        int e = 0;
#pragma unroll 1
        for (int step = 16; step >= 1; step >>= 1) e = (mt.pre[e + step] <= tau) ? e + step : e;
        const int ti = tau - mt.pre[e];
        u.rows = ltok + (size_t)e * T + ti * 256; u.nrows = min(256, mt.cnt[e] - ti * 256); u.pm = tau; u.pn = pn; u.a0 = e; u.a1 = 0;
        int ntv = UP ? 8 : 4; asm volatile("" : "+s"(ntv));
        if (UP) { u.A = A; u.lda2 = 1024; u.B = W + ((size_t)e * 1024 + pn * 256) * 1024; u.ldb2 = 1024; u.nt = ntv; }
        else { u.A = A + (size_t)tau * 256 * 512; u.lda2 = 512; u.B = W + ((size_t)e * 1024 + pn * 256) * 512; u.ldb2 = 512; u.nt = ntv; }
        return true; } };
constexpr float ACT8SCALE = 8.0f;
struct EpiUp {
    static constexpr bool PERM = true;
    unsigned char* ACT;
    __device__ __forceinline__ void operator()(const f32x4 (&acc)[2][2][4][2], const GUnit& u, int wr, int wc, int fr, int fq) const {
#pragma unroll
        for (int ai = 0; ai < 2; ++ai)
#pragma unroll
            for (int m = 0; m < 4; ++m) { f32x4 a = acc[ai][0][m][0] * (1.0f / W8SCALE), b = acc[ai][0][m][1] * (1.0f / W8SCALE);
#pragma unroll
                for (int e = 0; e < 4; ++e) { a[e] = a[e] * __builtin_amdgcn_rcpf(1.0f + __builtin_amdgcn_exp2f(-LOG2E * a[e])); b[e] = b[e] * __builtin_amdgcn_rcpf(1.0f + __builtin_amdgcn_exp2f(-LOG2E * b[e])); }
                a *= acc[ai][1][m][0] * (ACT8SCALE / W8SCALE); b *= acc[ai][1][m][1] * (ACT8SCALE / W8SCALE);
                u32x2 w; w.x = pk4_fp8(a[0], a[1], a[2], a[3]); w.y = pk4_fp8(b[0], b[1], b[2], b[3]);
                *(u32x2*)(ACT + (size_t)(u.pm * 256 + ai * 128 + wr * 64 + m * 16 + fr) * 512 + u.pn * 128 + wc * 32 + fq * 8) = w; }
    }
};
struct EpiDown {
    static constexpr bool PERM = true;
    bf16_t* YS2; const float* lw; const int* ltok;
    __device__ __forceinline__ void operator()(const f32x4 (&acc)[2][2][4][2], const GUnit& u, int wr, int wc, int fr, int fq) const {
        const size_t lb = (size_t)(u.rows - ltok);
        int dst[8]; float w[8];
#pragma unroll
        for (int i = 0; i < 8; ++i) { const int r = (i >> 2) * 128 + wr * 64 + (i & 3) * 16 + fr; const bool ok = r < u.nrows; dst[i] = ok ? u.rows[r] : -1; w[i] = lw[lb + (ok ? r : 0)]; }
        asm volatile("" ::: "memory");
#pragma unroll
        for (int ai = 0; ai < 2; ++ai)
#pragma unroll
            for (int m = 0; m < 4; ++m) { const int i = ai * 4 + m;
                if (dst[i] >= 0) {
#pragma unroll
                    for (int bj = 0; bj < 2; ++bj) *(u32x4*)(YS2 + (size_t)dst[i] * 1024 + u.pn * 256 + bj * 128 + wc * 32 + fq * 8) = pack8(acc[ai][bj][m][0] * (w[i] * (1.0f / (W8SCALE * ACT8SCALE))), acc[ai][bj][m][1] * (w[i] * (1.0f / (W8SCALE * ACT8SCALE)))); } }
    }
};

__device__ __forceinline__ void p_route1(const Frame& F0, int l) {
    const Frame F = phase_frame(F0);
    KParams& P = *F.p; const int nrows = l == 0 ? T : TX;
    LAS unsigned* wc = (LAS unsigned*)F.lds;
    const float* brg = P.in[I_BRG] + l * 4; const float* bre = P.in[I_BRE] + l * 32;
    for (int ch = F.bx; ch < nrows / 512; ch += F.G) {
        const int row = ch * 512 + F.tid;
        const float* lg = (const float*)(F.ws + WS_LOG) + (size_t)row * 64;
        const f32x4 g4 = *(const f32x4*)lg;
        float gl[4] = {g4[0] + brg[0], g4[1] + brg[1], g4[2] + brg[2], g4[3] + brg[3]};
        int gt = 0; float gm_ = gl[0];
#pragma unroll
        for (int i = 1; i < 4; ++i) if (gl[i] > gm_) { gm_ = gl[i]; gt = i; }
        float gs = 0.f;
#pragma unroll
        for (int i = 0; i < 4; ++i) gs += __expf(gl[i] - gm_);
        const float pgrp = 1.0f / gs;
        const f32x4 e0 = *(const f32x4*)(lg + 4 + gt * 8), e1 = *(const f32x4*)(lg + 8 + gt * 8);
        float le[8] = {e0[0], e0[1], e0[2], e0[3], e1[0], e1[1], e1[2], e1[3]};
#pragma unroll
        for (int i = 0; i < 8; ++i) le[i] += bre[gt * 8 + i];
        int i1 = 0; float v1 = le[0];
#pragma unroll
        for (int i = 1; i < 8; ++i) if (le[i] > v1) { v1 = le[i]; i1 = i; }
        int i2 = -1; float v2 = -INFINITY;
#pragma unroll
        for (int i = 0; i < 8; ++i) if (i != i1 && le[i] > v2) { v2 = le[i]; i2 = i; }
        if (i2 < 0) i2 = (i1 + 1) & 7;
        const float t2 = __expf(v2 - v1), w1 = pgrp / (1.0f + t2), w2 = pgrp * t2 / (1.0f + t2);
        const int ex1 = gt * 8 + i1, ex2 = gt * 8 + i2;
        const unsigned long long lt = (1ull << F.lane) - 1ull;
        unsigned r1 = 0, r2 = 0, mycnt = 0;
        for (int e = 0; e < 32; ++e) {
            const unsigned long long m1 = __builtin_amdgcn_ballot_w64(ex1 == e), m2 = __builtin_amdgcn_ballot_w64(ex2 == e);
            const unsigned below = (unsigned)__builtin_popcountll(m1 & lt) + (unsigned)__builtin_popcountll(m2 & lt);
            if (ex1 == e) r1 = below;
            if (ex2 == e) r2 = below;
            if (F.lane == e) mycnt = (unsigned)__builtin_popcountll(m1) + (unsigned)__builtin_popcountll(m2);
        }
        __syncthreads();
        if (F.lane < 32) wc[F.wave * 32 + F.lane] = mycnt;
        __syncthreads();
        for (int w = 0; w < F.wave; ++w) { r1 += wc[w * 32 + ex1]; r2 += wc[w * 32 + ex2]; }
        ((unsigned*)(F.ws + WS_REC))[row] = (unsigned)ex1 | ((unsigned)ex2 << 5) | (r1 << 10) | (r2 << 20);
        *(f32x2*)((float*)(F.ws + WS_RECW) + (size_t)row * 2) = (f32x2){w1, w2};
        if (F.tid < 32) { unsigned tot = 0;
#pragma unroll
            for (int w = 0; w < 8; ++w) tot += wc[w * 32 + F.tid];
            ((unsigned*)(F.ws + WS_CNTC))[ch * 32 + F.tid] = tot; }
    }
}
__device__ __forceinline__ void p_route2(const Frame& F0, int l) {
    const Frame F = phase_frame(F0);
    const int nrows = l == 0 ? T : TX;
    LAS unsigned* base = (LAS unsigned*)F.lds;
    int* ltok = (int*)(F.ws + WS_LTOK); float* lw = (float*)(F.ws + WS_LW);
    for (int ch = F.bx; ch < nrows / 512; ch += F.G) {
        __syncthreads();
        { const unsigned* cc = (const unsigned*)(F.ws + WS_CNTC) + (F.tid & 31); const int c0 = F.tid >> 5; unsigned b = 0, vv[9];
#pragma unroll
          for (int k = 0; k < 9; ++k) vv[k] = cc[min(c0 + 16 * k, max(ch, 1) - 1) * 32];
#pragma unroll
          for (int k = 0; k < 9; ++k) b += (c0 + 16 * k < ch) ? vv[k] : 0u;
          base[32 + F.tid] = b; }
        __syncthreads();
        if (F.tid < 32) { unsigned b = 0;
#pragma unroll
            for (int k = 0; k < 16; ++k) b += base[32 + k * 32 + F.tid];
            base[F.tid] = b; }
        __syncthreads();
        const int row = ch * 512 + F.tid;
        const unsigned rec = ((const unsigned*)(F.ws + WS_REC))[row]; const f32x2 w = *(const f32x2*)((const float*)(F.ws + WS_RECW) + (size_t)row * 2);
        const unsigned ex1 = rec & 31u, ex2 = (rec >> 5) & 31u, r1 = (rec >> 10) & 1023u, r2 = (rec >> 20) & 1023u;
        const size_t p1 = (size_t)ex1 * T + base[ex1] + r1, p2 = (size_t)ex2 * T + base[ex2] + r2;
        ltok[p1] = row * 2; lw[p1] = w[0]; ltok[p2] = row * 2 + 1; lw[p2] = w[1];
    }
}

__global__ void __launch_bounds__(512, 2) fwd_kernel(Params prm) {
    extern __shared__ __attribute__((aligned(16))) unsigned char lds_raw[];
    Frame F; F.p = (KParams*)__builtin_amdgcn_kernarg_segment_ptr(); F.ws = F.p->ws; F.dq = (unsigned char*)F.p->out; F.lds = (LAS unsigned char*)lds_raw;
    F.tid = threadIdx.x; F.lane = F.tid & 63; F.wave = __builtin_amdgcn_readfirstlane(F.tid >> 6); F.G = gridDim.x; F.bx = blockIdx.x;
    F.vcu = (F.G % 8 == 0) ? (F.bx % 8) * (F.G / 8) + F.bx / 8 : F.bx;
    const int lo = F.p->ph_lo, hi = F.p->ph_hi;
    if (F.tid < 4) ((LAS unsigned*)(F.lds + LDS_X))[F.tid] = 0u;
    __syncthreads();
    XcdBarrier bar; bar.bar = (unsigned*)CTLB(F); bar.x = 0; bar.st = (volatile LAS unsigned*)(F.lds + LDS_X);
    if (hi - lo > 1) bar = xcd_barrier_post((unsigned*)CTLB(F), (volatile LAS unsigned*)(F.lds + LDS_X));
#ifndef PHMASK
#define PHMASK 0xFFFF
#endif
#define IN(k) (lo <= (k) && (k) < hi)
#define EN(j) constexpr ((PHMASK >> (j)) & 1)

#define SEAM(k) do { if (IN(k) && IN((k) + 1)) xcd_barrier(bar); } while (0)
    if EN(0) if (IN(0)) { p0_prologue(F); }
    if EN(1) if (IN(1)) { p_norm_in(F); } SEAM(1);
    for (int l = 0; l < 2; ++l) {
        const int pb = 2 + 11 * l;
        const char* HX = (const char*)(F.ws + WS_HX);
        if EN(2) if (IN(pb + 0)) {
            EpiIn E{F.ws, F.dq};
            { SchedIn S{HX, (const char*)(F.ws + WS_WIN) + (size_t)l * NIN * 2048, l == 0 ? 272 : 256, 6, 0, F.G, F.bx}; gm::gemm_phase<SchedIn, EpiIn, 0, false>(F.lds, S, E); }
            { SchedIn S{HX, (const char*)(F.ws + WS_WIN) + (size_t)l * NIN * 2048, 272, 5, 6, F.G, F.G - 1 - F.bx}; gm::gemm_phase<SchedIn, EpiIn, 2, false>(F.lds, S, E); }
        }
        SEAM(pb + 0);
        if EN(3) if (IN(pb + 1)) { p_mixers(F, l); }
        SEAM(pb + 1);
        const bool zsplit = (l == 0) && (F.G == 256);
        unsigned* zctr = (unsigned*)(CTLB(F) + CTL_ZM);
#pragma unroll 1
        for (int st = 0; st < 2; ++st) {
            const bool run = st == 0 ? IN(pb + 2) : (zsplit && IN(pb + 3));
            if EN(4) if (run) {
                SchedMerge S{(const char*)(F.ws + WS_HX8), (const char*)(F.ws + WS_QA), (const char*)(F.ws + WS_WG8) + (size_t)l * 3072 * 1024,
                             (const char*)(F.ws + WS_WB) + (size_t)l * 3072 * 1024, st == 1 ? 16 : (l == 0 && !zsplit) ? 272 : 256, st == 1 ? 256 : 0, F.G, F.bx};
                EpiMerge E{(bf16_t*)(F.dq + DO_SIGS) + (size_t)F.bx * 65536, (bf16_t*)(F.dq + DO_M), F.ws + WS_M8};
                gm::gemm_phase<SchedMerge, EpiMerge, 0, false, 1>(F.lds, S, E);
                if (st == 1 && F.bx < 64) { int pm, pn; gm::static_tile(F.bx, 16, 4, pm, pn); zm_signal(zctr + 64 * pm); }
            }
            if (st == 0) SEAM(pb + 2);
        }
#pragma unroll 1
        for (int st = 0; st < 2; ++st) {
            const bool run = IN(pb + 3) && (st == 0 || (zsplit && F.bx >= 192));
            if EN(5) if (run) {
                SchedDense8 S{(const char*)(F.ws + WS_M8), (const char*)(F.ws + WS_WO) + (size_t)l * 1024 * 1024, l == 0 ? 272 : 256, 4, 0, F.bx, F.G, 1 << 30};
                if (zsplit) {
                    if (st == 1) { S.nM = 16; S.pm0 = 256; S.Lb = F.bx - 192; S.Ls = 1; S.imax = 1; int pm, pn; gm::static_tile(F.bx - 192, 16, 4, pm, pn); zm_wait(zctr + 64 * pm, 4u, bar.bar); }
                    else if (F.bx < 64) { S.nM = 256; S.Ls = 64; S.imax = 2; }
                    else { S.nM = 256; S.Lb = 128 + F.bx - 64; S.Ls = 192; }
                }
                EpiOut E{F.p->in[I_X], F.p->in[I_CTX], (bf16_t*)(F.ws + WS_XS), (const float*)(F.ws + WS_MOD) + (size_t)l * 17 * 6144, l};
                gm::gemm_phase<SchedDense8, EpiOut, 0, false, 5>(F.lds, S, E);
            }
        }
        SEAM(pb + 3);
        if EN(6) if (IN(pb + 4)) { p_norm2(F, l); }
        SEAM(pb + 4);
        if EN(7) if (IN(pb + 5)) {
            SchedDense S{HX, (const char*)(F.ws + WS_WR) + (size_t)l * 256 * 2048, l == 0 ? 272 : 256, 1, 0, F.bx, F.G, 1 << 30};
            EpiRouter E{(float*)(F.ws + WS_LOG)};
            gm::gemm_phase<SchedDense, EpiRouter, 0, false, 3>(F.lds, S, E);
        }
        SEAM(pb + 5);
        if EN(8) if (IN(pb + 6)) { p_route1(F, l); }
        SEAM(pb + 6);
        if EN(8) if (IN(pb + 7)) { p_route2(F, l); }
        SEAM(pb + 7);
        if EN(9) if (IN(pb + 8)) {
            MoeTab mt; moe_tables(F, l, mt);
            SchedMoe<true> S{mt, (const char*)(F.ws + WS_HX8), (const char*)(F.ws + WS_WGU) + (size_t)l * 32 * 1024 * 1024, (const int*)(F.ws + WS_LTOK), F.G, F.bx};
            EpiUp E{(unsigned char*)(F.dq + DO_ACT)};
            gm::gemm_phase<SchedMoe<true>, EpiUp, 0, true, 2>(F.lds, S, E);
        }
        SEAM(pb + 8);
        if EN(10) if (IN(pb + 9)) {
            MoeTab mt; moe_tables(F, l, mt);
            SchedMoe<false> S{mt, (const char*)(F.dq + DO_ACT), (const char*)(F.ws + WS_WD) + (size_t)l * 32 * 1024 * 512, (const int*)(F.ws + WS_LTOK), F.G, F.bx};
            EpiDown E{(bf16_t*)(F.ws + WS_YS2), (const float*)(F.ws + WS_LW), (const int*)(F.ws + WS_LTOK)};
            gm::gemm_phase<SchedMoe<false>, EpiDown, 0, false, 2>(F.lds, S, E);
        }
        SEAM(pb + 9);
        if EN(11) if (IN(pb + 10)) { p_combine(F, l); }
        SEAM(pb + 10);
    }
#undef IN
#undef SEAM
#if !MK_PER_PHASE
    {
        unsigned* ctl = (unsigned*)CTLB(F);
        volatile LAS unsigned* fl = (volatile LAS unsigned*)(F.lds + LDS_X + 64);
        __syncthreads();
        if (F.tid == 0) { asm volatile("s_waitcnt vmcnt(0)" ::: "memory"); fl[0] = (xb_add(&ctl[CTL_EXIT / 4], 1u) == (unsigned)F.G - 1u) ? 1u : 0u; }
        __syncthreads();
        if (fl[0]) {
            for (int i = F.tid; i < XCD_BAR_WORDS; i += 512) __hip_atomic_store(&ctl[i], 0u, __ATOMIC_RELAXED, __HIP_MEMORY_SCOPE_AGENT);
            if (F.tid < 16) __hip_atomic_store(&ctl[CTL_ZM / 4 + 64 * F.tid], 0u, __ATOMIC_RELAXED, __HIP_MEMORY_SCOPE_AGENT);
            if (F.tid == 16) __hip_atomic_store(&ctl[CTL_MODC / 4], 0u, __ATOMIC_RELAXED, __HIP_MEMORY_SCOPE_AGENT);
            if (F.tid == 17) __hip_atomic_store(&ctl[CTL_EXIT / 4], 0u, __ATOMIC_RELAXED, __HIP_MEMORY_SCOPE_AGENT);
        }
    }
#endif
}

extern "C" void kernel_launch(void* const* d_in, const int* in_sizes, int n_in, void* d_out, int out_size, void* d_ws, size_t ws_size, hipStream_t stream) {
    static int grid = 0;
    if (grid == 0) {
        if (n_in != 23 || out_size != TX * 1024 || ws_size < WS_END) { fprintf(stderr, "kernel_launch: unexpected shapes (n_in %d, out %d, ws %zu < %zu)\n", n_in, out_size, ws_size, (size_t)WS_END); grid = -1; return; }
        int dev = 0, cus = 0, per_cu = 0;
        if (hipGetDevice(&dev) != hipSuccess || hipDeviceGetAttribute(&cus, hipDeviceAttributeMultiprocessorCount, dev) != hipSuccess) { grid = -1; return; }
        if (hipFuncSetAttribute((const void*)fwd_kernel, hipFuncAttributeMaxDynamicSharedMemorySize, LDS_BYTES) != hipSuccess) { fprintf(stderr, "kernel_launch: hipFuncSetAttribute failed\n"); grid = -1; return; }
        if (hipOccupancyMaxActiveBlocksPerMultiprocessor(&per_cu, (const void*)fwd_kernel, 512, LDS_BYTES) != hipSuccess || per_cu < 1) { fprintf(stderr, "kernel_launch: occupancy query says %d\n", per_cu); }
        (void)hipGetLastError();
        grid = cus;
    }
    if (grid < 0) return;
#if MK_PER_PHASE
    if (hipMemsetAsync((char*)d_ws + WS_CTL, 0, CTL_BYTES, stream) != hipSuccess) return;
#endif
    Params p{};
    for (int i = 0; i < 23; ++i) p.in[i] = (const float*)d_in[i];
    p.out = (float*)d_out; p.ws = (unsigned char*)d_ws;
#if MK_PER_PHASE
    for (int k = 0; k < NPH; ++k) { p.ph_lo = k; p.ph_hi = k + 1; const int ty = k < 2 ? k : 2 + (k - 2) % 11;
        const int nr = 1 + ((PROBE_REPMASK >> ty) & 1);
        for (int r = 0; r < nr; ++r) { p.flags = (r + 1 < nr) ? (1 | PROBE_SUB) : 0; hipLaunchKernelGGL(fwd_kernel, dim3(grid), dim3(512), LDS_BYTES, stream, p); } }
#else
    p.ph_lo = 0; p.ph_hi = NPH;
    hipLaunchKernelGGL(fwd_kernel, dim3(grid), dim3(512), LDS_BYTES, stream, p);
#endif
}
```
